# Optimizing an MI355X kernel written in HIP

```python
import jax, jax.numpy as jnp
from jax import lax
import numpy as np

D_MODEL = 1024
BATCH = 2
SEQ = 16384
DEPTH = 1

HEAD_DIM = 64
ATTN_HEADS = 8
ATTN_WIDTH = ATTN_HEADS * HEAD_DIM
MOBA_BLOCK = 256
MOBA_TOPK = 3
Q_CHUNK = 32
ROPE_THETA = 10000.0

RWKV_HEADS = 8
RWKV_WIDTH = RWKV_HEADS * HEAD_DIM
DECAY_LORA = 64
AAA_LORA = 64
GATE_LORA = 160
GN_EPS = 64e-5

N_EXPERTS = 32
TOP_K = 4
D_EXPERT = 1024
SWIGLU_ALPHA = 1.702
SWIGLU_LIMIT = 7.0
EXPERT_BLOCK = 128

LN_EPS = 1e-5
DEEPNORM_ALPHA = (2 * DEPTH) ** 0.25
DEEPNORM_BETA = (8 * DEPTH) ** -0.25

OFF_R = 0
OFF_K = OFF_R + RWKV_WIDTH
OFF_V = OFF_K + RWKV_WIDTH
OFF_WD = OFF_V + RWKV_WIDTH
OFF_AD = OFF_WD + DECAY_LORA
OFF_GD = OFF_AD + AAA_LORA
SHIFT_COLS = OFF_GD + GATE_LORA
OFF_Q = SHIFT_COLS
OFF_AK = OFF_Q + ATTN_WIDTH
OFF_AV = OFF_AK + ATTN_WIDTH
OFF_GATE_A = OFF_AV + ATTN_WIDTH
OFF_GATE_R = OFF_GATE_A + D_MODEL
IN_COLS = OFF_GATE_R + D_MODEL

kernel_name = 'hybrid_moba_rwkv7_moe_deepnorm'


def layer_norm(x, g, b):
    xf = x.astype(jnp.float32)
    mu = xf.mean(-1, keepdims=True)
    var = jnp.square(xf - mu).mean(-1, keepdims=True)
    return ((xf - mu) * lax.rsqrt(var + LN_EPS) * g + b).astype(x.dtype)


def token_shift(t, mu):
    prev = jnp.pad(t, ((0, 0), (1, 0), (0, 0)))[:, :-1]
    return t + (prev - t) * mu


def rope(t):
    s = t.shape[1]
    half = HEAD_DIM // 2
    inv_freq = ROPE_THETA ** (-jnp.arange(half, dtype=jnp.float32) / half)
    ang = jnp.arange(s, dtype=jnp.float32)[:, None] * inv_freq[None, :]
    cos = jnp.cos(ang)[None, :, None, :]
    sin = jnp.sin(ang)[None, :, None, :]
    t1 = t[..., :half].astype(jnp.float32)
    t2 = t[..., half:].astype(jnp.float32)
    return jnp.concatenate([t1 * cos - t2 * sin, t2 * cos + t1 * sin], -1).astype(t.dtype)


def moba_attention(q, k, v):
    b, s, h, dh = q.shape
    nb = -(-s // MOBA_BLOCK)
    s_pad = nb * MOBA_BLOCK
    q, k = rope(q), rope(k)
    pad = ((0, 0), (0, s_pad - s), (0, 0), (0, 0))
    q, k, v = [jnp.pad(t, pad).transpose(0, 2, 1, 3) for t in (q, k, v)]
    kb = k.reshape(b, h, nb, MOBA_BLOCK, dh)
    vb = v.reshape(b, h, nb, MOBA_BLOCK, dh)
    k_mean = kb.astype(jnp.float32).mean(axis=3)
    topk = min(MOBA_TOPK, nb)
    n_chunks = s_pad // Q_CHUNK
    q_chunks = q.reshape(b, h, n_chunks, Q_CHUNK, dh).transpose(2, 0, 1, 3, 4)
    scale = dh ** -0.5
    gather = jax.vmap(jax.vmap(lambda blocks, idx: blocks[idx]))

    def one_chunk(args):
        c, qc = args
        blk = (c * Q_CHUNK) // MOBA_BLOCK
        q_pos = c * Q_CHUNK + jnp.arange(Q_CHUNK)
        gate = jnp.einsum('bhqd,bhnd->bhqn', qc.astype(jnp.float32), k_mean)
        gate = jnp.where(jnp.arange(nb) < blk, gate, -jnp.inf)
        _, sel = lax.top_k(gate, topk)
        sel_ok = sel < blk
        k_sel = gather(kb, sel)
        v_sel = gather(vb, sel)
        s_sel = jnp.einsum('bhqd,bhqjkd->bhqjk', qc, k_sel).astype(jnp.float32) * scale
        s_sel = jnp.where(sel_ok[..., None], s_sel, -jnp.inf).reshape(b, h, Q_CHUNK, topk * MOBA_BLOCK)
        k_own = lax.dynamic_index_in_dim(kb, blk, axis=2, keepdims=False)
        v_own = lax.dynamic_index_in_dim(vb, blk, axis=2, keepdims=False)
        s_own = jnp.einsum('bhqd,bhkd->bhqk', qc, k_own).astype(jnp.float32) * scale
        key_pos = blk * MOBA_BLOCK + jnp.arange(MOBA_BLOCK)
        s_own = jnp.where(key_pos[None, :] <= q_pos[:, None], s_own, -jnp.inf)
        p = jax.nn.softmax(jnp.concatenate([s_sel, s_own], -1), axis=-1).astype(v.dtype)
        p_sel = p[..., :topk * MOBA_BLOCK].reshape(b, h, Q_CHUNK, topk, MOBA_BLOCK)
        p_own = p[..., topk * MOBA_BLOCK:]
        return (jnp.einsum('bhqjk,bhqjkd->bhqd', p_sel, v_sel)
                + jnp.einsum('bhqk,bhkd->bhqd', p_own, v_own))

    out = lax.map(one_chunk, (jnp.arange(n_chunks), q_chunks))
    return out.transpose(1, 0, 3, 2, 4).reshape(b, s_pad, h * dh)[:, :s]


def rwkv7_time_mix(r, k, v, h_w, h_a, h_g, w0, w_decay_up, a0, w_aaa_up, w_gate_up,
                   k_k, k_a, r_k, lnx_g, lnx_b):
    b, s, _ = r.shape
    nh, n = RWKV_HEADS, HEAD_DIM
    f32 = jnp.float32
    w_log = -jax.nn.softplus(-(w0 + jnp.tanh(h_w) @ w_decay_up).astype(f32)) - 0.5
    decay = jnp.exp(-jnp.exp(w_log))
    a = jax.nn.sigmoid((a0 + h_a @ w_aaa_up).astype(f32))
    g = jax.nn.sigmoid(h_g) @ w_gate_up
    kk = (k * k_k).astype(f32).reshape(b, s, nh, n)
    kk = kk / jnp.maximum(jnp.sqrt(jnp.sum(kk * kk, -1, keepdims=True)), 1e-12)
    k = k * (1.0 + (a - 1.0) * k_a)
    to_heads = lambda t: t.astype(f32).reshape(b, s, nh, n)
    r_h, k_h, v_h, a_h, w_h = to_heads(r), to_heads(k), to_heads(v), to_heads(a), to_heads(decay)
    seq_first = lambda t: jnp.swapaxes(t, 0, 1)

    def step(state, inp):
        r_t, w_t, k_t, v_t, kk_t, a_t = inp
        s_kk = jnp.einsum('bhvk,bhk->bhv', state, kk_t)
        state = (state * w_t[:, :, None, :]
                 - s_kk[..., None] * (kk_t * a_t)[:, :, None, :]
                 + v_t[..., None] * k_t[:, :, None, :])
        return state, jnp.einsum('bhvk,bhk->bhv', state, r_t)

    state0 = jnp.zeros((b, nh, n, n), f32)
    _, y = lax.scan(step, state0, [seq_first(t) for t in (r_h, w_h, k_h, v_h, kk, a_h)])
    y = seq_first(y)
    mu = y.mean(-1, keepdims=True)
    var = jnp.square(y - mu).mean(-1, keepdims=True)
    y = ((y - mu) * lax.rsqrt(var + GN_EPS)).reshape(b, s, nh * n) * lnx_g + lnx_b
    bonus = (jnp.sum(r_h * k_h * r_k, -1, keepdims=True) * v_h).reshape(b, s, nh * n)
    return ((y + bonus) * g).astype(r.dtype)


def clamped_swiglu(h):
    h = h.astype(jnp.float32)
    x_glu = jnp.minimum(h[..., ::2], SWIGLU_LIMIT)
    x_lin = jnp.clip(h[..., 1::2], -SWIGLU_LIMIT, SWIGLU_LIMIT)
    return x_glu * jax.nn.sigmoid(SWIGLU_ALPHA * x_glu) * (x_lin + 1.0)


def moe_ffn(x, w_router, b_router, w1, b1, w2, b2):
    b, s, d = x.shape
    t = b * s
    n_slots = t * TOP_K
    xt = x.reshape(t, d)
    logits = (xt @ w_router + b_router).astype(jnp.float32)
    top_vals, top_idx = lax.top_k(logits, TOP_K)
    gates = jax.nn.softmax(top_vals, axis=-1)
    flat_e = top_idx.reshape(-1)
    flat_tok = jnp.arange(n_slots, dtype=jnp.int32) // TOP_K
    flat_g = gates.reshape(-1)
    order = jnp.argsort(flat_e)
    e_sorted = flat_e[order]
    counts = jnp.bincount(flat_e, length=N_EXPERTS)
    starts = jnp.cumsum(counts) - counts
    padded = (counts + EXPERT_BLOCK - 1) // EXPERT_BLOCK * EXPERT_BLOCK
    pad_ends = jnp.cumsum(padded)
    pad_starts = pad_ends - padded
    dest = pad_starts[e_sorted] + (jnp.arange(n_slots) - starts[e_sorted])
    n_blocks = -(-n_slots // EXPERT_BLOCK) + N_EXPERTS
    cap = n_blocks * EXPERT_BLOCK
    slot_tok = jnp.full((cap,), t, jnp.int32).at[dest].set(flat_tok[order])
    slot_gate = jnp.zeros((cap,), jnp.float32).at[dest].set(flat_g[order])
    block_start = jnp.arange(n_blocks) * EXPERT_BLOCK
    block_expert = jnp.minimum(jnp.searchsorted(pad_ends, block_start, side='right'), N_EXPERTS - 1)
    x_pad = jnp.concatenate([xt, jnp.zeros((1, d), xt.dtype)], axis=0)

    def block_step(acc, inp):
        tok, gate, e = inp
        hid = x_pad[tok] @ w1[e] + b1[e]
        y = clamped_swiglu(hid).astype(w2.dtype) @ w2[e] + b2[e]
        return acc.at[tok].add(y.astype(jnp.float32) * gate[:, None]), None

    acc0 = jnp.zeros((t + 1, d), jnp.float32)
    acc, _ = lax.scan(block_step, acc0, (slot_tok.reshape(n_blocks, EXPERT_BLOCK),
                                          slot_gate.reshape(n_blocks, EXPERT_BLOCK), block_expert))
    return acc[:t].reshape(b, s, d).astype(x.dtype)


def hybrid_layer(x, w_in, mu_shift, w0, w_decay_up, a0, w_aaa_up, w_gate_up, k_k, k_a, r_k,
                 lnx_g, lnx_b, w_attn_br, w_rwkv_br, w_out, ln1_g, ln1_b,
                 w_router, b_router, w1, b1, w2, b2, ln2_g, ln2_b):
    b, s, _ = x.shape
    proj = x @ w_in
    sh = token_shift(proj[..., :SHIFT_COLS], mu_shift)
    y_rwkv = rwkv7_time_mix(sh[..., OFF_R:OFF_K], sh[..., OFF_K:OFF_V], sh[..., OFF_V:OFF_WD],
                            sh[..., OFF_WD:OFF_AD], sh[..., OFF_AD:OFF_GD], sh[..., OFF_GD:SHIFT_COLS],
                            w0, w_decay_up, a0, w_aaa_up, w_gate_up, k_k, k_a, r_k, lnx_g, lnx_b)
    heads = lambda t: t.reshape(b, s, ATTN_HEADS, HEAD_DIM)
    y_attn = moba_attention(heads(proj[..., OFF_Q:OFF_AK]), heads(proj[..., OFF_AK:OFF_AV]),
                            heads(proj[..., OFF_AV:OFF_GATE_A]))
    mixed = (jax.nn.sigmoid(proj[..., OFF_GATE_A:OFF_GATE_R]) * (y_attn @ w_attn_br)
             + jax.nn.sigmoid(proj[..., OFF_GATE_R:]) * (y_rwkv @ w_rwkv_br))
    h = layer_norm(DEEPNORM_ALPHA * x + mixed @ w_out, ln1_g, ln1_b)
    return layer_norm(DEEPNORM_ALPHA * h + moe_ffn(h, w_router, b_router, w1, b1, w2, b2), ln2_g, ln2_b)


def setup_inputs(seed: int = 0) -> dict:
    key = jax.random.key(seed)
    ks = iter(jax.random.split(key, 40))
    nrm = lambda shape, scale: jax.random.normal(next(ks), shape, jnp.float32) * scale
    L, D, E, F = DEPTH, D_MODEL, N_EXPERTS, D_EXPERT
    return {
        'x': nrm((BATCH, SEQ, D), 1.0),
        'w_in': nrm((L, D, IN_COLS), D ** -0.5),
        'mu_shift': jax.random.uniform(next(ks), (L, SHIFT_COLS), jnp.float32),
        'w0': nrm((L, RWKV_WIDTH), 0.5),
        'w_decay_up': nrm((L, DECAY_LORA, RWKV_WIDTH), DECAY_LORA ** -0.5),
        'a0': nrm((L, RWKV_WIDTH), 0.1),
        'w_aaa_up': nrm((L, AAA_LORA, RWKV_WIDTH), AAA_LORA ** -0.5),
        'w_gate_up': nrm((L, GATE_LORA, RWKV_WIDTH), GATE_LORA ** -0.5),
        'k_k': 0.85 + nrm((L, RWKV_WIDTH), 0.05),
        'k_a': 1.0 + nrm((L, RWKV_WIDTH), 0.05),
        'r_k': nrm((L, RWKV_HEADS, HEAD_DIM), 0.1),
        'lnx_g': 1.0 + nrm((L, RWKV_WIDTH), 0.02),
        'lnx_b': nrm((L, RWKV_WIDTH), 0.02),
        'w_attn_br': nrm((L, ATTN_WIDTH, D), ATTN_WIDTH ** -0.5),
        'w_rwkv_br': nrm((L, RWKV_WIDTH, D), RWKV_WIDTH ** -0.5),
        'w_out': nrm((L, D, D), D ** -0.5 * DEEPNORM_BETA),
        'ln1_g': 1.0 + nrm((L, D), 0.02),
        'ln1_b': nrm((L, D), 0.02),
        'w_router': nrm((L, D, E), D ** -0.5),
        'b_router': nrm((L, E), 0.01),
        'w1': nrm((L, E, D, 2 * F), D ** -0.5),
        'b1': nrm((L, E, 2 * F), 0.01),
        'w2': nrm((L, E, F, D), F ** -0.5 * DEEPNORM_BETA),
        'b2': nrm((L, E, D), 0.01),
        'ln2_g': 1.0 + nrm((L, D), 0.02),
        'ln2_b': nrm((L, D), 0.02),
    }


def reference(x, w_in, mu_shift, w0, w_decay_up, a0, w_aaa_up, w_gate_up, k_k, k_a, r_k,
              lnx_g, lnx_b, w_attn_br, w_rwkv_br, w_out, ln1_g, ln1_b,
              w_router, b_router, w1, b1, w2, b2, ln2_g, ln2_b):
    for l in range(DEPTH):
        x = hybrid_layer(x, w_in[l], mu_shift[l], w0[l], w_decay_up[l], a0[l], w_aaa_up[l],
                         w_gate_up[l], k_k[l], k_a[l], r_k[l], lnx_g[l], lnx_b[l],
                         w_attn_br[l], w_rwkv_br[l], w_out[l], ln1_g[l], ln1_b[l],
                         w_router[l], b_router[l], w1[l], b1[l], w2[l], b2[l], ln2_g[l], ln2_b[l])
    return x
```

```cpp
#include <hip/hip_runtime.h>
#include <cstdio>
#include <cstdint>

#define GAS __attribute__((address_space(1)))
#define LAS __attribute__((address_space(3)))
#define CAS __attribute__((address_space(4)))
typedef unsigned short bf16;
typedef unsigned v4u __attribute__((ext_vector_type(4)));
typedef unsigned v2u __attribute__((ext_vector_type(2)));
typedef float f32x4 __attribute__((ext_vector_type(4)));
typedef float f32x2 __attribute__((ext_vector_type(2)));
typedef short bf16x8 __attribute__((ext_vector_type(8)));
typedef GAS unsigned gu32;
#define RLX_AGENT __ATOMIC_RELAXED, __HIP_MEMORY_SCOPE_AGENT
#define LDS_WAIT() asm volatile("s_waitcnt lgkmcnt(0)" ::: "memory")
#define VM_WAIT() asm volatile("s_waitcnt vmcnt(0)" ::: "memory")

#ifndef REPEAT_MASK
#define REPEAT_MASK 0
#endif
#define REPS(k) for (int rep = 0; rep < 1 + (((REPEAT_MASK) >> (k)) & 1); ++rep)
constexpr int NWAVES = 8, NTHR = 512;
constexpr int T = 32768, D = 1024, SEQ = 16384, NBLK = 64  ;
constexpr int IN_COLS = 5408, NPROJ = 5632  ;
constexpr int OFF_Q = 1824, OFF_AK = 2336, OFF_AV = 2848, OFF_GA = 3360, OFF_GR = 4384, RWC = 1824;
constexpr int NEXP = 32, FF = 1024, NSLOT_MAX = 4 * T + NEXP * 256  , NTILE_MAX = NSLOT_MAX / 256  ;
constexpr int RCH = 128  , NCH = SEQ / RCH  ;
constexpr float LN_EPS = 1e-5f, GN_EPS = 64e-5f, ALPHA = 1.189207115002721f, SW_ALPHA = 1.702f, SW_LIMIT = 7.0f;

constexpr size_t MiB = 1u << 20;
constexpr size_t WS_CTL = 0, ZERO_BYTES = 2 * MiB;
constexpr size_t WS_KMEAN = 1 * MiB;
constexpr size_t WS_ROWIDX = 1 * MiB + 256 * 1024;
constexpr size_t WS_ROPE = 2 * MiB;
constexpr size_t WS_WBR = 6 * MiB, WS_WOUT = 8 * MiB, WS_WLORA = 10 * MiB;
constexpr size_t WS_TILEE = 11 * MiB;
constexpr size_t WS_SEL = 12 * MiB;
constexpr size_t WS_STATS = 13 * MiB;
constexpr size_t WS_TOPE = WS_STATS + 256 * 1024, WS_TOPG = WS_TOPE + 512 * 1024, WS_TOKSLOT = WS_TOPG + 512 * 1024, WS_SLOTG = WS_TOKSLOT + 512 * 1024;
constexpr size_t WS_QR = 16 * MiB, WS_KR = 48 * MiB, WS_VR = 80 * MiB;
constexpr size_t WS_SGA = 112 * MiB, WS_SGR = 176 * MiB;
constexpr size_t WS_XB = 240 * MiB, WS_WIN = 304 * MiB;
constexpr size_t WS_APR = 872 * MiB;
constexpr size_t WS_YB = 240 * MiB;
constexpr size_t WS_RW = 320 * MiB;
constexpr size_t WS_MN = 320 * MiB, WS_HC = 384 * MiB, WS_PO = 416 * MiB, WS_PM = 544 * MiB, WS_PL = 548 * MiB;
constexpr size_t WS_PRE = 552 * MiB;
constexpr size_t WS_MIXED = 872 * MiB;
constexpr size_t WS_W1T = 16 * MiB, WS_W2T = 144 * MiB, WS_HB = 208 * MiB, WS_XG = 272 * MiB, WS_ACT = 544 * MiB, WS_YS = 272 * MiB;
constexpr size_t WS_END = 936 * MiB;
constexpr int CW_TMO = 0, CW_ATTQ = 64, CW_NTILES = 128, CW_ECNT = 192, CW_ECUR = 256, CW_BAR = 4096;

constexpr int RING_BYTES = 131072, MISC_OFF = 147456, LDS_BYTES = 154624;

__device__ __forceinline__ unsigned pk2(float lo, float hi) { unsigned r; asm("v_cvt_pk_bf16_f32 %0, %1, %2" : "=v"(r) : "v"(lo), "v"(hi)); return r; }
__device__ __forceinline__ unsigned f2bf(float f) { return pk2(f, f) & 0xffffu; }
__device__ __forceinline__ float bf2f(unsigned b) { return __builtin_bit_cast(float, b << 16); }
__device__ __forceinline__ float bflo(unsigned w) { return __builtin_bit_cast(float, w << 16); }
__device__ __forceinline__ float bfhi(unsigned w) { return __builtin_bit_cast(float, w & 0xffff0000u); }
__device__ __forceinline__ float wave_sum(float v) {
#pragma unroll
    for (int o = 1; o < 64; o <<= 1) v += __shfl_xor(v, o);
    return v;
}
__device__ __forceinline__ unsigned lds_add(LAS unsigned* p, unsigned v) { return __hip_atomic_fetch_add(p, v, __ATOMIC_RELAXED, __HIP_MEMORY_SCOPE_WORKGROUP); }
__device__ __forceinline__ float sigmoidf_(float x) { return 1.0f / (1.0f + __expf(-x)); }

namespace pg8 {
constexpr int BM = 256, BK = 64, HALF = 128, HTB = HALF * BK * 2, STAGE_BYTES = 8 * HTB;
__host__ __device__ __forceinline__ int lds_byte(int r, int c) { const int st = (r >> 4) * 2 + (c >> 5), rr = r & 15, cc = c & 31, ob = rr * 64 + cc * 2; return st * 1024 + (ob ^ (((ob >> 9) & 1) << 5)); }
__host__ __device__ __forceinline__ void stage_rc(int b, int& R, int& C) { const int st = b / 1024, sb = b % 1024, swz = sb ^ (((sb >> 9) & 1) << 5); R = (st >> 1) * 16 + swz / 64; C = (st & 1) * 32 + (swz % 64) / 2; }
__host__ __device__ __forceinline__ int perm32(int rho) { const int n = rho >> 4, i = rho & 15; return 8 * (i >> 2) + 4 * n + (i & 3); }

struct Unit { int pm, pn; unsigned aoff, boff; int aux; };
struct Gemm { const bf16* A; const bf16* Bt; int K, lda, ldb; const int* rowidx; };

__device__ __forceinline__ unsigned cvt_pk_bf16(float lo, float hi) { unsigned r; asm volatile("v_cvt_pk_bf16_f32 %0, %1, %2" : "=v"(r) : "v"(lo), "v"(hi)); return r; }

#ifndef PG8_ALIGN_EPI
#define PG8_ALIGN_EPI 1
#endif
template <class Epi, class Sched, bool GATHER = false>
__device__ __forceinline__ void gemm_phase(LAS unsigned char* lds, const Gemm g, const Sched& S, const Epi& E) {
    const int tid = threadIdx.x, wid = __builtin_amdgcn_readfirstlane(tid >> 6), lane = tid & 63, wr = wid >> 2, wc = wid & 3, fr = lane & 15, fq = lane >> 4;
    int nt = g.K / BK; asm volatile("" : "+s"(nt));
    unsigned voffA[2], voffB[2];
#pragma unroll
    for (int i = 0; i < 2; ++i) { int R, C; stage_rc(tid * 16 + i * 8192, R, C); const int Rb = (R & ~31) + perm32(R & 31);
        voffA[i] = (unsigned)(R * g.lda + C) * 2u; voffB[i] = (unsigned)(Rb * g.ldb + C) * 2u; }
    const size_t kstep = (size_t)(BK * 2);
    unsigned gaC[2][2], gaN[2][2];
#define PG8_ROWS(ga, U) do { _Pragma("unroll") for (int _h = 0; _h < 2; ++_h) _Pragma("unroll") for (int _i = 0; _i < 2; ++_i) { int R, C; stage_rc(tid * 16 + _i * 8192, R, C); \
        ga[_h][_i] = (unsigned)g.rowidx[(U).pm * 256 + _h * 128 + R] * (unsigned)(g.lda * 2) + (unsigned)C * 2u; } } while (0)
#define PG8_STA(bufoff, nx, kb, h) do { if constexpr (GATHER) { unsigned _v[2]; _v[0] = (nx) ? gaN[h][0] : gaC[h][0]; _v[1] = (nx) ? gaN[h][1] : gaC[h][1]; PG8_STAGE(bufoff, (const char*)g.A + (kb), _v); } \
        else { PG8_STAGE(bufoff, ((nx) ? nA : cA) + (kb) + (h) * hstepA, voffA); } } while (0)
    const size_t hstepA = (size_t)HALF * g.lda * 2, hstepB = (size_t)HALF * g.ldb * 2;
    const size_t tstepA = 2 * hstepA, tstepB = 2 * hstepB;
    const unsigned ldsw = (unsigned)wid * 1024u;
    const int aoff = lds_byte(wr * 64 + fr, fq * 8), boff = lds_byte(wc * 32 + fr, fq * 8);
#define PG8_SA(b, h) (((b) * 2 + (h)) * HTB)
#define PG8_SB(b, h) ((4 + (b) * 2 + (h)) * HTB)
#define PG8_STAGE(bufoff, gbase, voff) do { _Pragma("unroll") for (int _i = 0; _i < 2; ++_i) \
        __builtin_amdgcn_global_load_lds((const unsigned*)((const char*)(gbase) + (voff)[_i]), (LAS unsigned*)(lds + (bufoff) + ldsw + _i * 8192), 16, 0, 0); } while (0)
#define PG8_LDA(dst, b, h) do { _Pragma("unroll") for (int m = 0; m < 4; ++m) _Pragma("unroll") for (int k = 0; k < 2; ++k) dst[m][k] = *(const LAS bf16x8*)(lds + PG8_SA(b, h) + aoff + m * 2048 + k * 1024); } while (0)
#define PG8_LDB(dst, b, h) do { _Pragma("unroll") for (int n = 0; n < 2; ++n) _Pragma("unroll") for (int k = 0; k < 2; ++k) dst[n][k] = *(const LAS bf16x8*)(lds + PG8_SB(b, h) + boff + n * 2048 + k * 1024); } while (0)
#define PG8_MMA(ai, bj, At, Bt) do { __builtin_amdgcn_s_setprio(1); _Pragma("unroll") for (int m = 0; m < 4; ++m) _Pragma("unroll") for (int n = 0; n < 2; ++n) _Pragma("unroll") for (int k = 0; k < 2; ++k) \
        acc[ai][bj][m][n] = __builtin_amdgcn_mfma_f32_16x16x32_bf16(Bt[n][k], At[m][k], acc[ai][bj][m][n], 0, 0, 0); __builtin_amdgcn_s_setprio(0); } while (0)
#define PG8_WAIT_V(n) asm volatile("s_waitcnt vmcnt(" #n ")" ::: "memory")
#define PG8_WAIT_L(n) asm volatile("s_waitcnt lgkmcnt(" #n ")" ::: "memory")
#define PG8_BAR __builtin_amdgcn_s_barrier()
#define PG8_SCHED __builtin_amdgcn_sched_barrier(0)
    Unit cur, nxt; int ui = 0;
    if (!S.next(0, cur)) return;
    f32x4 acc[2][2][4][2];
#pragma unroll
    for (int a = 0; a < 2; ++a)
#pragma unroll
        for (int b = 0; b < 2; ++b)
#pragma unroll
            for (int m = 0; m < 4; ++m)
#pragma unroll
                for (int n = 0; n < 2; ++n) acc[a][b][m][n] = (f32x4){0.f, 0.f, 0.f, 0.f};
    bf16x8 At[4][2], B0[2][2], B1[2][2];
    const char* cA = (const char*)g.A + (size_t)cur.pm * tstepA + cur.aoff; const char* cB = (const char*)g.Bt + (size_t)cur.pn * tstepB + cur.boff;
    const char* nA = cA;
    if constexpr (GATHER) PG8_ROWS(gaC, cur);
    PG8_STAGE(PG8_SB(0, 0), cB, voffB); PG8_STAGE(PG8_SB(0, 1), cB + hstepB, voffB); PG8_STA(PG8_SA(0, 0), false, 0, 0); PG8_STA(PG8_SA(0, 1), false, 0, 1);
    if (wr == 1) PG8_BAR;
    PG8_WAIT_V(2); PG8_BAR;
    PG8_STAGE(PG8_SB(1, 0), cB + kstep, voffB); PG8_STA(PG8_SA(1, 0), false, kstep, 0); PG8_STAGE(PG8_SB(1, 1), cB + hstepB + kstep, voffB);
    PG8_WAIT_V(6); PG8_BAR;
    for (;;) {
        const bool has_next = S.next(ui + 1, nxt);
        nA = has_next ? (const char*)g.A + (size_t)nxt.pm * tstepA + nxt.aoff : cA;
        if constexpr (GATHER) { if (has_next) PG8_ROWS(gaN, nxt); else { _Pragma("unroll") for (int _h = 0; _h < 2; ++_h) { gaN[_h][0] = gaC[_h][0]; gaN[_h][1] = gaC[_h][1]; } } }
        const char* nB = has_next ? (const char*)g.Bt + (size_t)nxt.pn * tstepB + nxt.boff : cB;
        for (int t = 0; t < nt; t += 2) {
            const bool last = (t == nt - 2);
            const size_t k1 = (size_t)(t + 1) * kstep, k2 = last ? 0 : (size_t)(t + 2) * kstep, k3 = k2 + kstep;
            const char* b2 = last ? nB : cB + (size_t)(t + 2) * kstep; const char* b3 = b2 + kstep;
            PG8_LDB(B0, 0, 0); PG8_LDB(B1, 0, 1); PG8_SCHED; PG8_LDA(At, 0, 0); PG8_STA(PG8_SA(1, 1), false, k1, 1);
            PG8_WAIT_V(8); PG8_WAIT_L(0); PG8_BAR; PG8_MMA(0, 0, At, B0); PG8_MMA(0, 1, At, B1); PG8_BAR; PG8_SCHED;
            PG8_LDA(At, 0, 1); PG8_STAGE(PG8_SB(0, 0), b2, voffB); PG8_STAGE(PG8_SB(0, 1), b2 + hstepB, voffB); PG8_STA(PG8_SA(0, 0), last, k2, 0);
            PG8_WAIT_V(8); PG8_WAIT_L(0); PG8_BAR; PG8_MMA(1, 0, At, B0); PG8_MMA(1, 1, At, B1); PG8_BAR; PG8_SCHED;
            PG8_LDB(B0, 1, 0); PG8_LDB(B1, 1, 1); PG8_SCHED; PG8_LDA(At, 1, 0); PG8_STA(PG8_SA(0, 1), last, k2, 1);
            PG8_WAIT_V(8); PG8_WAIT_L(0); PG8_BAR; PG8_MMA(0, 0, At, B0); PG8_MMA(0, 1, At, B1); PG8_BAR; PG8_SCHED;
            PG8_LDA(At, 1, 1); PG8_STAGE(PG8_SB(1, 0), b3, voffB); PG8_STAGE(PG8_SB(1, 1), b3 + hstepB, voffB); PG8_STA(PG8_SA(1, 0), last, k3, 0);
            PG8_WAIT_V(8); PG8_WAIT_L(0); PG8_BAR; PG8_MMA(1, 0, At, B0); PG8_MMA(1, 1, At, B1); PG8_BAR; PG8_SCHED;
        }
        if (PG8_ALIGN_EPI && wr == 0) PG8_BAR;
        E(acc, cur, wr, wc, fr, fq);
        if (!has_next) break;
#pragma unroll
        for (int a = 0; a < 2; ++a)
#pragma unroll
            for (int b = 0; b < 2; ++b)
#pragma unroll
                for (int m = 0; m < 4; ++m)
#pragma unroll
                    for (int n = 0; n < 2; ++n) acc[a][b][m][n] = (f32x4){0.f, 0.f, 0.f, 0.f};
        cur = nxt; cA = nA; cB = nB; ++ui;
        if constexpr (GATHER) { _Pragma("unroll") for (int _h = 0; _h < 2; ++_h) { gaC[_h][0] = gaN[_h][0]; gaC[_h][1] = gaN[_h][1]; } }
        if (PG8_ALIGN_EPI && wr == 1) PG8_BAR;
    }
    PG8_WAIT_V(0);
    if (!PG8_ALIGN_EPI && wr == 0) PG8_BAR;
    PG8_BAR;
#undef PG8_SA
#undef PG8_ROWS
#undef PG8_STA
#undef PG8_SB
#undef PG8_STAGE
#undef PG8_LDA
#undef PG8_LDB
#undef PG8_MMA
#undef PG8_WAIT_V
#undef PG8_WAIT_L
#undef PG8_BAR
#undef PG8_SCHED
}
}

#define XB_TMO      128
#define XB_XCNT(j)  (256  + 64 * (j))
#define XB_XSUB(j)  (1280 + 64 * (j))
#define XB_XGEN(j)  (2304 + 64 * (j))
#define XB_TOP      3328
#define XB_TOPGEN   3392
#define XCD_BAR_WORDS 3456
#define XB_SPIN_CAP (1u << 22)

__device__ __forceinline__ unsigned xb_ld(unsigned* p)              { return __hip_atomic_load(p, __ATOMIC_RELAXED, __HIP_MEMORY_SCOPE_AGENT); }
__device__ __forceinline__ unsigned xb_add(unsigned* p, unsigned v) { return __hip_atomic_fetch_add(p, v, __ATOMIC_RELAXED, __HIP_MEMORY_SCOPE_AGENT); }
__device__ __forceinline__ unsigned xb_xcc_id() { return (unsigned)__builtin_amdgcn_s_getreg((3 << 11) | 20) & 0xFu; }
#define XB_SPIN(cond, bar) do { unsigned _sp = 0; while (cond) { __builtin_amdgcn_s_sleep(1); \
    if ((++_sp & 255u) == 0u) { if (xb_ld(&(bar)[XB_TMO])) break; if (_sp > XB_SPIN_CAP) { atomicAdd(&(bar)[XB_TMO], 1u); break; } } } } while (0)

struct XcdBarrier { unsigned* bar; unsigned x; volatile LAS unsigned* st; };

__device__ __forceinline__ XcdBarrier xcd_barrier_post(unsigned* bar, volatile LAS unsigned* st) {
    XcdBarrier b; b.bar = bar; b.x = xb_xcc_id(); b.st = st;
    if (threadIdx.x == 0) (void)xb_add(&bar[XB_XCNT(b.x)], 1u);
    return b;
}
__device__ __forceinline__ void xcd_barrier_complete(unsigned* bar, unsigned x, unsigned& nloc, unsigned& nx) {
    const unsigned G = gridDim.x * gridDim.y * gridDim.z;
    unsigned sum, cnt, mine, sp = 0u;
    for (;;) {
        sum = 0u; cnt = 0u; mine = 0u;
#pragma unroll
        for (unsigned j = 0; j < 16; ++j) { const unsigned c = xb_ld(&bar[XB_XCNT(j)]); sum += c; cnt += (c > 0u) ? 1u : 0u; mine = (j == x) ? c : mine; }
        if (sum == G) break;
        __builtin_amdgcn_s_sleep(1);
        if ((++sp & 255u) == 0u) { if (xb_ld(&bar[XB_TMO])) break; if (sp > XB_SPIN_CAP) { atomicAdd(&bar[XB_TMO], 1u); break; } }
    }
    nloc = mine > 0u ? mine : 1u; nx = cnt > 0u ? cnt : 1u;
}
__device__ __forceinline__ void xcd_barrier(const XcdBarrier& b) {
    asm volatile("s_waitcnt vmcnt(0)" ::: "memory");
    __syncthreads();
    if (threadIdx.x == 0) {
        unsigned* bar = b.bar;
        __builtin_amdgcn_s_waitcnt(0);
        unsigned nloc = b.st[0], nx = b.st[1];
        if (nloc == 0u) { xcd_barrier_complete(bar, b.x, nloc, nx); b.st[0] = nloc; b.st[1] = nx; }
        const unsigned old = xb_add(&bar[XB_XSUB(b.x)], 1u);
        const unsigned gen = old / nloc;
        if (old + 1u == (gen + 1u) * nloc) {
            __builtin_amdgcn_fence(__ATOMIC_RELEASE, "agent");
            asm volatile("s_waitcnt vmcnt(0)" ::: "memory");
            const unsigned og = xb_add(&bar[XB_TOP], 1u);
            const unsigned tg = og / nx;
            if (og + 1u == (tg + 1u) * nx) xb_add(&bar[XB_TOPGEN], 1u);
            else XB_SPIN(xb_ld(&bar[XB_TOPGEN]) == tg, bar);
            __builtin_amdgcn_fence(__ATOMIC_ACQUIRE, "agent");
            xb_add(&bar[XB_XGEN(b.x)], 1u);
            asm volatile("s_waitcnt vmcnt(0)" ::: "memory");
        } else {
            XB_SPIN(xb_ld(&bar[XB_XGEN(b.x)]) == gen, bar);
            __builtin_amdgcn_fence(__ATOMIC_ACQUIRE, "agent");
            asm volatile("s_waitcnt vmcnt(0)" ::: "memory");
        }
    }
    __syncthreads();
}

__device__ __forceinline__ int proj_srccol(int n) {
    if (n < 1024) { const int base = (n < 512) ? OFF_Q : OFF_AK; const int m = n & 511, h = m >> 6, p = m & 63; return base + h * 64 + (p >> 1) + 32 * (p & 1); }
    if (n < 1536) return OFF_AV + (n - 1024);
    if (n < 2560) return OFF_GA + (n - 1536);
    if (n < 3584) return OFF_GR + (n - 2560);
    if (n < 3584 + RWC) return n - 3584;
    return -1;
}
template <bool MAP>
__device__ __forceinline__ void transpose_item(const float* W, int N, bf16* WT, int ldk, int k0, int n0, int kdst0, LAS float* scr, int lane) {
    const int nl = lane & 31;
    int col = n0 + nl; if (MAP) col = proj_srccol(col);
    float tv[32];
#pragma unroll
    for (int i = 0; i < 32; ++i) { const int kk = 2 * i + (lane >> 5); tv[i] = (col >= 0) ? W[(size_t)(k0 + kk) * N + col] : 0.f; }
#pragma unroll
    for (int i = 0; i < 32; ++i) { const int kk = 2 * i + (lane >> 5); scr[kk * 33 + nl] = tv[i]; }
    LDS_WAIT(); asm volatile("" ::: "memory");
    const int c = lane & 7;
#pragma unroll
    for (int j = 0; j < 4; ++j) { const int n = (lane >> 3) + 8 * j; const LAS float* s = scr + (8 * c) * 33 + n;
        v4u o; o.x = pk2(s[0 * 33], s[1 * 33]); o.y = pk2(s[2 * 33], s[3 * 33]); o.z = pk2(s[4 * 33], s[5 * 33]); o.w = pk2(s[6 * 33], s[7 * 33]);
        *(GAS v4u*)(WT + (size_t)(n0 + n) * ldk + kdst0 + k0 + 8 * c) = o; }
    LDS_WAIT(); asm volatile("" ::: "memory");
}

struct GridOrder {
    int nM, nN, nwg, G, c, rsh; unsigned asec;
    __device__ __forceinline__ void init(int nM_, int nN_, int G_, int c_, unsigned asec_, int rsh_) { nM = nM_; nN = nN_; nwg = nM * nN; G = G_; c = c_; asec = asec_; rsh = rsh_; }
    __device__ __forceinline__ bool next(int i, pg8::Unit& u) const {
        const long L = (long)(i >> rsh) * G + c; if (L >= nwg) return false;
        int wgid = (int)L; { const int q = nwg / 8, r = nwg % 8, xcd = wgid % 8, off = wgid / 8; wgid = (xcd < r ? xcd * (q + 1) : r * (q + 1) + (xcd - r) * q) + off; }
#ifndef GO_WGM
#define GO_WGM 4
#endif
        const int nig = GO_WGM * nN, gid = wgid / nig, fm = gid * GO_WGM, gsz = (nM - fm) < GO_WGM ? (nM - fm) : GO_WGM;
        u.pm = fm + ((wgid % nig) % gsz); u.pn = (wgid % nig) / gsz; u.aoff = asec * (unsigned)(u.pn >> 1); u.boff = 0u; u.aux = 0; return true;
    }
};
struct MixOrder {
    int G, c, rsh;
    __device__ __forceinline__ bool next(int i, pg8::Unit& u) const {
        int tl; if (G == 256) tl = (c & 7) * 64 + (i >> (1 + rsh)) * 32 + (c >> 3); else tl = (i >> (1 + rsh)) * G + c;
        if (tl >= 512 || (G == 256 && (i >> (1 + rsh)) >= 2)) return false;
        u.pm = tl >> 2; u.pn = tl & 3; u.aux = i & 1; u.aoff = u.boff = (unsigned)(i & 1) * 1024u; return true;
    }
};
struct MoeOrder {
    int G, c, nN, ntiles; const int* tile_e; unsigned estride; int rsh;
    __device__ __forceinline__ bool next(int i, pg8::Unit& u) const {
        const int U = ntiles * nN; int L;
        if ((G & 7) == 0) { const int perX = (U + 7) >> 3, cpx = G >> 3, li = (i >> rsh) * cpx + (c >> 3); if (li >= perX) return false; L = (c & 7) * perX + li; if (L >= U) return false; }
        else { L = (i >> rsh) * G + c; if (L >= U) return false; }
#ifndef MOE_WGM
#define MOE_WGM 4
#endif
        { const int gsz0 = MOE_WGM * nN, gi = L / gsz0, fm = gi * MOE_WGM, rem = ntiles - fm, gr = rem < MOE_WGM ? rem : MOE_WGM, uu = L - gi * gsz0; u.pm = fm + uu % gr; u.pn = uu / gr; }
        const int e = __builtin_nontemporal_load(tile_e + u.pm); u.aux = e; u.aoff = 0u; u.boff = (unsigned)e * estride; return true;
    }
};

#define EPI_ARGS const f32x4 (&acc)[2][2][4][2], const pg8::Unit& u, int wr, int wc, int fr, int fq
__device__ __forceinline__ v4u pack8(const f32x4 a, const f32x4 b) { v4u w; w.x = pg8::cvt_pk_bf16(a[0], a[1]); w.y = pg8::cvt_pk_bf16(a[2], a[3]); w.z = pg8::cvt_pk_bf16(b[0], b[1]); w.w = pg8::cvt_pk_bf16(b[2], b[3]); return w; }

struct EpiProj {
    bf16 *QR, *KR, *VR, *SGA, *SGR; float *KMEAN; const float* ROPE;
    float *PRE, *PREV, *RAW0, *RAW63; bf16* APR; const float* mu_shift;
    __device__ __forceinline__ void operator()(EPI_ARGS) const {
        const int pn = u.pn, row0 = u.pm * 256 + wr * 64 + fr, bb = u.pm >> 6;
        if (pn < 4) {
            const bool isk = pn >= 2;
            float ks[2][8];
#pragma unroll
            for (int bj = 0; bj < 2; ++bj)
#pragma unroll
                for (int e = 0; e < 8; ++e) ks[bj][e] = 0.f;
#pragma unroll
            for (int ai2 = 0; ai2 < 4; ++ai2) { const int ai = ai2 >> 1, mb = (ai2 & 1) * 2;
                f32x4 cq[4][2], sq[4][2];
#pragma unroll
                for (int m = mb; m < mb + 2; ++m)
#pragma unroll
                    for (int bj = 0; bj < 2; ++bj) { const int s_ = (row0 + ai * 128 + m * 16) & (SEQ - 1), i0 = ((bj * 128 + wc * 32 + 8 * fq) & 63) >> 1;
                        cq[m][bj] = *(const f32x4*)(ROPE + (size_t)s_ * 32 + i0); sq[m][bj] = *(const f32x4*)(ROPE + (size_t)SEQ * 32 + (size_t)s_ * 32 + i0); }
#pragma unroll
                for (int m = mb; m < mb + 2; ++m) {
                    const int t = row0 + ai * 128 + m * 16, s_ = t & (SEQ - 1);
#pragma unroll
                    for (int bj = 0; bj < 2; ++bj) {
                        const int cs = (pn & 1) * 256 + bj * 128 + wc * 32 + 8 * fq, h = cs >> 6, p0 = cs & 63;
                        const f32x4 c4 = cq[m][bj], s4 = sq[m][bj];
                        const f32x4 v0 = acc[ai][bj][m][0], v1 = acc[ai][bj][m][1];
                        f32x4 o0, o1;
                        o0[0] = v0[0] * c4[0] - v0[1] * s4[0]; o0[1] = v0[1] * c4[0] + v0[0] * s4[0];
                        o0[2] = v0[2] * c4[1] - v0[3] * s4[1]; o0[3] = v0[3] * c4[1] + v0[2] * s4[1];
                        o1[0] = v1[0] * c4[2] - v1[1] * s4[2]; o1[1] = v1[1] * c4[2] + v1[0] * s4[2];
                        o1[2] = v1[2] * c4[3] - v1[3] * s4[3]; o1[3] = v1[3] * c4[3] + v1[2] * s4[3];
                        bf16* dst = (isk ? KR : QR) + (((size_t)(bb * 8 + h) * SEQ + s_) * 64 + p0);
                        if (isk) {
#pragma unroll
                            for (int e = 0; e < 4; ++e) { ks[bj][e] += o0[e]; ks[bj][4 + e] += o1[e]; }
                        } else { o0 = o0 * 0.125f; o1 = o1 * 0.125f; }
                        *(v4u*)dst = pack8(o0, o1);
                    }
                }
                asm volatile("" ::: "memory");
            }
            if (isk) {
#pragma unroll
                for (int bj = 0; bj < 2; ++bj)
#pragma unroll
                    for (int e = 0; e < 8; ++e) { float v = ks[bj][e]; v += __shfl_xor(v, 1); v += __shfl_xor(v, 2); v += __shfl_xor(v, 4); v += __shfl_xor(v, 8); ks[bj][e] = v; }
                if (fr == 0) {
#pragma unroll
                    for (int bj = 0; bj < 2; ++bj) {
                        const int cs = (pn & 1) * 256 + bj * 128 + wc * 32 + 8 * fq, h = cs >> 6, p0 = cs & 63;
                        float* km = KMEAN + ((size_t)((bb * 8 + h) * NBLK + (u.pm & 63)) * 64 + p0);
#pragma unroll
                        for (int e = 0; e < 8; ++e) atomicAdd(km + e, ks[bj][e]);
                    }
                }
            }
        } else if (pn < 6) {
#pragma unroll
            for (int ai = 0; ai < 2; ++ai)
#pragma unroll
                for (int m = 0; m < 4; ++m) {
                    const int t = row0 + ai * 128 + m * 16, s = t & (SEQ - 1);
#pragma unroll
                    for (int bj = 0; bj < 2; ++bj) {
                        const int cs = (pn & 1) * 256 + bj * 128 + wc * 32 + 8 * fq, h = cs >> 6, p0 = cs & 63;
                        *(v4u*)(VR + (((size_t)(bb * 8 + h) * SEQ + s) * 64 + p0)) = pack8(acc[ai][bj][m][0], acc[ai][bj][m][1]);
                    }
                }
        } else if (pn < 14) {
            bf16* G = (pn < 10) ? SGA : SGR; const int cb = ((pn - 6) & 3) * 256;
#pragma unroll
            for (int ai = 0; ai < 2; ++ai)
#pragma unroll
                for (int m = 0; m < 4; ++m) {
                    const int t = row0 + ai * 128 + m * 16;
#pragma unroll
                    for (int bj = 0; bj < 2; ++bj) {
                        const int cs = cb + bj * 128 + wc * 32 + 8 * fq;
                        f32x4 a = acc[ai][bj][m][0], b = acc[ai][bj][m][1];
#pragma unroll
                        for (int e = 0; e < 4; ++e) { a[e] = sigmoidf_(a[e]); b[e] = sigmoidf_(b[e]); }
                        *(v4u*)(G + (size_t)t * 1024 + cs) = pack8(a, b);
                    }
                }
        } else {
            const int seg = (pn - 14) >> 1;
            f32x4 mq[2][2];
#pragma unroll
            for (int bj = 0; bj < 2; ++bj) { const int r = (pn - 14) * 256 + bj * 128 + wc * 32 + 8 * fq;
                if (r < RWC) { mq[bj][0] = *(const f32x4*)(mu_shift + r); mq[bj][1] = *(const f32x4*)(mu_shift + r + 4); } else { mq[bj][0] = (f32x4){0.f, 0.f, 0.f, 0.f}; mq[bj][1] = mq[bj][0]; } }
#pragma unroll
            for (int ai = 0; ai < 2; ++ai)
#pragma unroll
                for (int m = 0; m < 4; ++m) {
                    const int t = row0 + ai * 128 + m * 16;
#pragma unroll
                    for (int bj = 0; bj < 2; ++bj) {
                        const int r = (pn - 14) * 256 + bj * 128 + wc * 32 + 8 * fq, rl = r & 511;
                        f32x4 c0 = acc[ai][bj][m][0], c1 = acc[ai][bj][m][1], p0, p1;
#pragma unroll
                        for (int e = 0; e < 4; ++e) {
                            float up0 = 0.f, up1 = 0.f; const float x0 = c0[e], x1 = c1[e];
                            asm volatile("s_nop 1\n\tv_mov_b32_dpp %0, %1 row_shr:1 row_mask:0xf bank_mask:0xf" : "+v"(up0) : "v"(x0));
                            asm volatile("s_nop 1\n\tv_mov_b32_dpp %0, %1 row_shr:1 row_mask:0xf bank_mask:0xf" : "+v"(up1) : "v"(x1));
                            if (m > 0) {
                                float cy0 = 0.f, cy1 = 0.f; const float y0 = acc[ai][bj][m > 0 ? m - 1 : 0][0][e], y1 = acc[ai][bj][m > 0 ? m - 1 : 0][1][e];
                                asm volatile("s_nop 1\n\tv_mov_b32_dpp %0, %1 row_newbcast:15 row_mask:0xf bank_mask:0xf" : "+v"(cy0) : "v"(y0));
                                asm volatile("s_nop 1\n\tv_mov_b32_dpp %0, %1 row_newbcast:15 row_mask:0xf bank_mask:0xf" : "+v"(cy1) : "v"(y1));
                                up0 = fr == 0 ? cy0 : up0; up1 = fr == 0 ? cy1 : up1;
                            }
                            p0[e] = up0; p1[e] = up1;
                        }
                        f32x4 s0 = c0 + (p0 - c0) * mq[bj][0], s1 = c1 + (p1 - c1) * mq[bj][1];
                        if (m == 0 && fr == 0) { s0 = c0; s1 = c1; float* d = RAW0 + (size_t)(t >> 6) * 2048 + r; *(f32x4*)d = c0; *(f32x4*)(d + 4) = c1; }
                        if (m == 3 && fr == 15) { float* d = RAW63 + (size_t)(t >> 6) * 2048 + r; *(f32x4*)d = c0; *(f32x4*)(d + 4) = c1; }
                        if (seg == 0) { float* d = PRE + ((size_t)t * 8 + (rl >> 6)) * 320 + 256 + (rl & 63); *(f32x4*)d = s0; *(f32x4*)(d + 4) = s1; }
                        else if (seg == 1) { float* d = PRE + ((size_t)t * 8 + (rl >> 6)) * 320 + 192 + (rl & 63); *(f32x4*)d = s0; *(f32x4*)(d + 4) = s1; }
                        else if (seg == 2) { float* d = PREV + (size_t)t * 512 + rl; *(f32x4*)d = s0; *(f32x4*)(d + 4) = s1; }
                        else {
                            const int kind = rl < 64 ? 0 : (rl < 128 ? 1 : 2);
#pragma unroll
                            for (int e = 0; e < 4; ++e) {
                                if (kind == 0) { s0[e] = 2.0f * sigmoidf_(2.0f * s0[e]) - 1.0f; s1[e] = 2.0f * sigmoidf_(2.0f * s1[e]) - 1.0f; }
                                else if (kind == 2) { s0[e] = sigmoidf_(s0[e]); s1[e] = sigmoidf_(s1[e]); } }
                            *(v4u*)(APR + (size_t)t * 512 + rl) = pack8(s0, s1);
                        }
                    }
                    asm volatile("" ::: "memory");
                }
        }
    }
};

struct EpiLora {
    float *PRE, *G; const float *w0, *a0;
    __device__ __forceinline__ void operator()(EPI_ARGS) const {
        const int sec = u.pn >> 1, row0 = u.pm * 256 + wr * 64 + fr, cb = (u.pn & 1) * 256 + wc * 32 + 8 * fq;
        if (sec < 2) {
            const float* cst = sec ? a0 : w0; f32x4 wq[2][2];
#pragma unroll
            for (int bj = 0; bj < 2; ++bj) { wq[bj][0] = *(const f32x4*)(cst + cb + bj * 128); wq[bj][1] = *(const f32x4*)(cst + cb + bj * 128 + 4); }
#pragma unroll
            for (int ai = 0; ai < 2; ++ai) {
#pragma unroll
                for (int m = 0; m < 4; ++m)
#pragma unroll
                    for (int bj = 0; bj < 2; ++bj) {
                        const int t = row0 + ai * 128 + m * 16, c = cb + bj * 128;
                        float* pre = PRE + ((size_t)t * 8 + (c >> 6)) * 320 + (c & 63) + (sec ? 128 : 64);
                        f32x4 o0, o1;
#pragma unroll
                        for (int e = 0; e < 4; ++e) {
                            const float z0 = sigmoidf_(wq[bj][0][e] + acc[ai][bj][m][0][e]), z1 = sigmoidf_(wq[bj][1][e] + acc[ai][bj][m][1][e]);
                            o0[e] = sec ? z0 : __expf(-0.6065306597126334f * z0); o1[e] = sec ? z1 : __expf(-0.6065306597126334f * z1); }
                        *(f32x4*)pre = o0; *(f32x4*)(pre + 4) = o1;
                    }
                asm volatile("" ::: "memory");
            }
        } else {
#pragma unroll
            for (int ai = 0; ai < 2; ++ai)
#pragma unroll
                for (int m = 0; m < 4; ++m)
#pragma unroll
                    for (int bj = 0; bj < 2; ++bj) {
                        const int t = row0 + ai * 128 + m * 16, c = cb + bj * 128;
                        float* d = G + (size_t)t * 512 + c; *(f32x4*)d = acc[ai][bj][m][0]; *(f32x4*)(d + 4) = acc[ai][bj][m][1];
                    }
        }
    }
};

struct EpiMix {
    bf16 *MIXED; const bf16 *SGA, *SGR;
    __device__ __forceinline__ void operator()(EPI_ARGS) const {
        const int row0 = u.pm * 256 + wr * 64 + fr; const bf16* SG = u.aux ? SGR : SGA;
        const size_t cofs = (size_t)u.pn * 256 + wc * 32 + 8 * fq;
#pragma unroll
        for (int ai = 0; ai < 2; ++ai) {
            v4u gq[4][2], pq[4][2];
#pragma unroll
            for (int m = 0; m < 4; ++m)
#pragma unroll
                for (int bj = 0; bj < 2; ++bj) { const size_t off = (size_t)(row0 + ai * 128 + m * 16) * 1024 + cofs + bj * 128; gq[m][bj] = *(const v4u*)(SG + off); if (u.aux) pq[m][bj] = *(const v4u*)(MIXED + off); }
#pragma unroll
            for (int m = 0; m < 4; ++m)
#pragma unroll
                for (int bj = 0; bj < 2; ++bj) {
                    const size_t off = (size_t)(row0 + ai * 128 + m * 16) * 1024 + cofs + bj * 128; const v4u g = gq[m][bj];
                    f32x4 a = acc[ai][bj][m][0], b = acc[ai][bj][m][1];
                    a[0] *= bflo(g.x); a[1] *= bfhi(g.x); a[2] *= bflo(g.y); a[3] *= bfhi(g.y); b[0] *= bflo(g.z); b[1] *= bfhi(g.z); b[2] *= bflo(g.w); b[3] *= bfhi(g.w);
                    if (u.aux) { const v4u p = pq[m][bj];
                        a[0] += bflo(p.x); a[1] += bfhi(p.x); a[2] += bflo(p.y); a[3] += bfhi(p.y); b[0] += bflo(p.z); b[1] += bfhi(p.z); b[2] += bflo(p.w); b[3] += bfhi(p.w); }
                    *(v4u*)(MIXED + off) = pack8(a, b);
                }
            asm volatile("" ::: "memory");
        }
    }
};

struct EpiOut {
    float* PRE1; const float* X;
    __device__ __forceinline__ void operator()(EPI_ARGS) const {
        const int row0 = u.pm * 256 + wr * 64 + fr; const size_t cofs = (size_t)u.pn * 256 + wc * 32 + 8 * fq;
#pragma unroll
        for (int ai = 0; ai < 2; ++ai) {
            f32x4 x0[4][2], x1[4][2];
#pragma unroll
            for (int m = 0; m < 4; ++m)
#pragma unroll
                for (int bj = 0; bj < 2; ++bj) { const size_t off = (size_t)(row0 + ai * 128 + m * 16) * 1024 + cofs + bj * 128; x0[m][bj] = *(const f32x4*)(X + off); x1[m][bj] = *(const f32x4*)(X + off + 4); }
#pragma unroll
            for (int m = 0; m < 4; ++m)
#pragma unroll
                for (int bj = 0; bj < 2; ++bj) { const size_t off = (size_t)(row0 + ai * 128 + m * 16) * 1024 + cofs + bj * 128;
                    *(f32x4*)(PRE1 + off) = x0[m][bj] * ALPHA + acc[ai][bj][m][0]; *(f32x4*)(PRE1 + off + 4) = x1[m][bj] * ALPHA + acc[ai][bj][m][1]; }
            asm volatile("" ::: "memory");
        }
    }
};

struct EpiW1 {
    bf16* ACT; const float* b1;
    __device__ __forceinline__ void operator()(EPI_ARGS) const {
        const int row0 = u.pm * 256 + wr * 64 + fr; const float* be = b1 + (size_t)u.aux * 2048 + u.pn * 256 + wc * 32 + 8 * fq;
        f32x4 bv[2][2];
#pragma unroll
        for (int bj = 0; bj < 2; ++bj) { bv[bj][0] = *(const f32x4*)(be + bj * 128); bv[bj][1] = *(const f32x4*)(be + bj * 128 + 4); }
#pragma unroll
        for (int ai = 0; ai < 2; ++ai) {
#pragma unroll
            for (int m = 0; m < 4; ++m) {
                const int r = row0 + ai * 128 + m * 16;
#pragma unroll
                for (int bj = 0; bj < 2; ++bj) {
                    const int c = u.pn * 256 + bj * 128 + wc * 32 + 8 * fq;
                    const f32x4 h0 = acc[ai][bj][m][0] + bv[bj][0], h1 = acc[ai][bj][m][1] + bv[bj][1];
                    float o[4];
#pragma unroll
                    for (int e = 0; e < 4; ++e) { const float gl = fminf(e < 2 ? h0[2 * e] : h1[2 * e - 4], SW_LIMIT); float ln = e < 2 ? h0[2 * e + 1] : h1[2 * e - 3]; ln = fminf(fmaxf(ln, -SW_LIMIT), SW_LIMIT);
                        o[e] = gl * sigmoidf_(SW_ALPHA * gl) * (ln + 1.0f); }
                    v2u w; w.x = pg8::cvt_pk_bf16(o[0], o[1]); w.y = pg8::cvt_pk_bf16(o[2], o[3]);
                    *(v2u*)(ACT + (size_t)r * 1024 + (c >> 1)) = w;
                }
            }
            asm volatile("" ::: "memory");
        }
    }
};

struct EpiW2 {
    bf16* YS; const float* b2; const float* SLOTG;
    __device__ __forceinline__ void operator()(EPI_ARGS) const {
        const int row0 = u.pm * 256 + wr * 64 + fr; const float* be = b2 + (size_t)u.aux * 1024 + u.pn * 256 + wc * 32 + 8 * fq;
        f32x4 bv[2][2]; float gt[2][4];
#pragma unroll
        for (int bj = 0; bj < 2; ++bj) { bv[bj][0] = *(const f32x4*)(be + bj * 128); bv[bj][1] = *(const f32x4*)(be + bj * 128 + 4); }
#pragma unroll
        for (int ai = 0; ai < 2; ++ai)
#pragma unroll
            for (int m = 0; m < 4; ++m) gt[ai][m] = SLOTG[row0 + ai * 128 + m * 16];
#pragma unroll
        for (int ai = 0; ai < 2; ++ai) {
#pragma unroll
            for (int m = 0; m < 4; ++m) {
                const int r = row0 + ai * 128 + m * 16;
#pragma unroll
                for (int bj = 0; bj < 2; ++bj) {
                    const int c = u.pn * 256 + bj * 128 + wc * 32 + 8 * fq;
                    const f32x4 y0 = (acc[ai][bj][m][0] + bv[bj][0]) * gt[ai][m], y1 = (acc[ai][bj][m][1] + bv[bj][1]) * gt[ai][m];
                    *(v4u*)(YS + (size_t)r * 1024 + c) = pack8(y0, y1);
                }
            }
            asm volatile("" ::: "memory");
        }
    }
};

__device__ __forceinline__ void phase_p0(const float* x, const float* w_in, const float* w_abr, const float* w_rbr, const float* w_out,
                                         const float* w_du, const float* w_au, const float* w_gu, unsigned char* ws, LAS unsigned char* lds, int gw, int NGW, int wave, int lane) {
    LAS float* scr = (LAS float*)(lds + wave * 16384);
    bf16* WIN = (bf16*)(ws + WS_WIN); bf16* WBR = (bf16*)(ws + WS_WBR); bf16* WOUT = (bf16*)(ws + WS_WOUT); bf16* WLORA = (bf16*)(ws + WS_WLORA);
    constexpr int I_IN = 16 * (NPROJ / 32), I_BR = 8 * 32, I_OUT = 16 * 32;
    constexpr int NITEMS = I_IN + 2 * I_BR + I_OUT;
    for (int it = gw; it < NITEMS; it += NGW) {
        int r = it;
        if (r < I_IN) { const int nb = r % (NPROJ / 32), kb = r / (NPROJ / 32); transpose_item<true>(w_in, IN_COLS, WIN, 1024, 64 * kb, 32 * nb, 0, scr, lane); continue; } r -= I_IN;
        if (r < I_BR) { transpose_item<false>(w_abr, 1024, WBR, 1024, 64 * (r / 32), 32 * (r % 32), 0, scr, lane); continue; } r -= I_BR;
        if (r < I_BR) { transpose_item<false>(w_rbr, 1024, WBR, 1024, 64 * (r / 32), 32 * (r % 32), 512, scr, lane); continue; } r -= I_BR;
        transpose_item<false>(w_out, 1024, WOUT, 1024, 64 * (r / 32), 32 * (r % 32), 0, scr, lane);
    }
    const int gt = gw * 64 + lane, NGT = NGW * 64;
    for (int i = gt; i < 1536 * 256; i += NGT) { const int n = i >> 8, k = i & 255, sec = n >> 9, c = n & 511;
        float v = 0.f; if (sec == 0) { if (k < 64) v = w_du[k * 512 + c]; } else if (sec == 1) { if (k < 64) v = w_au[k * 512 + c]; } else { if (k < 160) v = w_gu[k * 512 + c]; }
        WLORA[i] = (bf16)f2bf(v); }
    float* ROPE = (float*)(ws + WS_ROPE);
    for (int i = gt; i < SEQ * 32; i += NGT) { const int s = i >> 5, f = i & 31; const double inv = pow(10000.0, -(double)f / 32.0), ang = (double)s * inv; double sn, cs; sincos(ang, &sn, &cs);
        ROPE[i] = (float)cs; ROPE[SEQ * 32 + i] = (float)sn; }
    bf16* XB = (bf16*)(ws + WS_XB);
    for (size_t i0 = gt; i0 < (size_t)T * 1024 / 8; i0 += (size_t)NGT * 4) {
        f32x4 a[4], b[4];
#pragma unroll
        for (int q = 0; q < 4; ++q) { const size_t i = i0 + (size_t)q * NGT; if (i < (size_t)T * 128) { a[q] = *(const f32x4*)(x + i * 8); b[q] = *(const f32x4*)(x + i * 8 + 4); } }
#pragma unroll
        for (int q = 0; q < 4; ++q) { const size_t i = i0 + (size_t)q * NGT; if (i < (size_t)T * 128) {
            v4u o; o.x = pk2(a[q][0], a[q][1]); o.y = pk2(a[q][2], a[q][3]); o.z = pk2(b[q][0], b[q][1]); o.w = pk2(b[q][2], b[q][3]); *(v4u*)(XB + i * 8) = o; } }
    }
}

__device__ __forceinline__ float tshift(float cur, float prev, float mu) { return cur + (prev - cur) * mu; }
__device__ __forceinline__ void phase_p2_fix(const float* mu_shift, unsigned char* ws, float* PREV, int gw, int NGW, int lane) {
    const float* RAW0 = (const float*)(ws + WS_RW); const float* RAW63 = RAW0 + (size_t)(T / 64) * 2048; float* PRE = (float*)(ws + WS_PRE); bf16* APR = (bf16*)(ws + WS_APR);
    const int gt = gw * 64 + lane, NGT = NGW * 64;
    for (int i0 = gt; i0 < (T / 64) * 2048; i0 += NGT * 8) {
        float cv[8], pv[8], mv[8];
#pragma unroll
        for (int q = 0; q < 8; ++q) { const int idx = i0 + q * NGT; const int ii = idx < (T / 64) * 2048 ? idx : i0; const int n = ii >> 11, c = ii & 2047;
            const bool hp = ((n * 64) & (SEQ - 1)) != 0;
            cv[q] = RAW0[ii]; pv[q] = RAW63[hp ? ii - 2048 : ii]; mv[q] = mu_shift[c < RWC ? c : 0]; }
#pragma unroll
        for (int q = 0; q < 8; ++q) { const int idx = i0 + q * NGT; if (idx < (T / 64) * 2048) {
            const int n = idx >> 11, c = idx & 2047, t = n * 64, rl = c & 511; const bool hp = (t & (SEQ - 1)) != 0;
            const float sh = tshift(cv[q], hp ? pv[q] : 0.f, c < RWC ? mv[q] : 0.f);
            if (c < 512) PRE[((size_t)t * 8 + (rl >> 6)) * 320 + 256 + (rl & 63)] = sh;
            else if (c < 1024) PRE[((size_t)t * 8 + (rl >> 6)) * 320 + 192 + (rl & 63)] = sh;
            else if (c < 1536) PREV[(size_t)t * 512 + rl] = sh;
            else { const float a = rl < 64 ? 2.0f * sigmoidf_(2.0f * sh) - 1.0f : (rl < 128 ? sh : sigmoidf_(sh)); APR[(size_t)t * 512 + rl] = (bf16)f2bf(a); } } }
    }
}
__device__ __forceinline__ void phase_p2_gate(unsigned char* ws, LAS unsigned char* lds, int gw, int NGW, int wave, int lane) {
    const bf16* QR = (const bf16*)(ws + WS_QR); const float* KMEAN = (const float*)(ws + WS_KMEAN); unsigned* SEL = (unsigned*)(ws + WS_SEL);
    LAS float* km = (LAS float*)(lds + wave * 16384);
    for (int it = gw; it < 4096; it += NGW) {
        const int q4 = it & 3, ib = (it >> 2) & 63, h = (it >> 8) & 7, b = it >> 11, i = b ? 63 - ib : ib;
        const float* kmg = KMEAN + (size_t)((b * 8 + h) * NBLK) * 64;
        for (int j0 = 0; j0 < i; j0 += 8) {
            float kv[8];
#pragma unroll
            for (int q = 0; q < 8; ++q) { const int jj = (j0 + q < i) ? j0 + q : i - 1; kv[q] = kmg[jj * 64 + lane]; }
#pragma unroll
            for (int q = 0; q < 8; ++q) if (j0 + q < i) km[(j0 + q) * 64 + lane] = kv[q] * (1.0f / 256.0f);
        }
        LDS_WAIT(); asm volatile("" ::: "memory");
        const int s = i * 256 + q4 * 64 + lane, t = b * SEQ + s;
        const bf16* qrow = QR + ((size_t)(b * 8 + h) * SEQ + s) * 64;
        float q[64];
#pragma unroll
        for (int c = 0; c < 8; ++c) { const v4u w = *(const v4u*)(qrow + c * 8);
            q[c * 8 + 0] = bflo(w.x); q[c * 8 + 1] = bfhi(w.x); q[c * 8 + 2] = bflo(w.y); q[c * 8 + 3] = bfhi(w.y); q[c * 8 + 4] = bflo(w.z); q[c * 8 + 5] = bfhi(w.z); q[c * 8 + 6] = bflo(w.w); q[c * 8 + 7] = bfhi(w.w); }
        float b0 = -__builtin_inff(), b1 = b0, b2 = b0; unsigned i0 = 255u, i1 = 255u, i2 = 255u;
        for (int j = 0; j < i; ++j) {
            const LAS f32x4* kj = (const LAS f32x4*)(km + j * 64);
            float d0 = 0.f, d1 = 0.f, d2 = 0.f, d3 = 0.f;
#pragma unroll
            for (int c = 0; c < 16; ++c) { const f32x4 kv = kj[c]; d0 += q[4 * c] * kv[0]; d1 += q[4 * c + 1] * kv[1]; d2 += q[4 * c + 2] * kv[2]; d3 += q[4 * c + 3] * kv[3]; }
            const float dot = (d0 + d1) + (d2 + d3);
            if (dot > b0) { b2 = b1; i2 = i1; b1 = b0; i1 = i0; b0 = dot; i0 = (unsigned)j; }
            else if (dot > b1) { b2 = b1; i2 = i1; b1 = dot; i1 = (unsigned)j; }
            else if (dot > b2) { b2 = dot; i2 = (unsigned)j; }
        }
        SEL[(size_t)t * 8 + h] = i0 | (i1 << 8) | (i2 << 16) | 0xFF000000u;
        LDS_WAIT(); asm volatile("" ::: "memory");
    }
}

template <int N, int MODE = 0> __device__ __forceinline__ void fmac_bc(float& acc, float src, float other) {
    if constexpr (MODE == 0) asm volatile("v_fmac_f32_dpp %0, %1, %2 row_newbcast:%3 row_mask:0xf bank_mask:0xf" : "+v"(acc) : "v"(src), "v"(other), "n"(N));
    else if constexpr (MODE == 1) asm volatile("v_fmac_f32_dpp %0, %1, %2 quad_perm:[%3,%3,%3,%3] row_mask:0xf bank_mask:0xf" : "+v"(acc) : "v"(src), "v"(other), "n"(N & 3));
    else asm volatile("v_fmac_f32_e32 %0, %1, %2" : "+v"(acc) : "v"(src), "v"(other));
}
template <int N, int MODE = 0> __device__ __forceinline__ void mul_bc(float& h, float src) {
    if constexpr (MODE == 0) asm volatile("v_mul_f32_dpp %0, %1, %0 row_newbcast:%2 row_mask:0xf bank_mask:0xf" : "+v"(h) : "v"(src), "n"(N));
    else if constexpr (MODE == 1) asm volatile("v_mul_f32_dpp %0, %1, %0 quad_perm:[%2,%2,%2,%2] row_mask:0xf bank_mask:0xf" : "+v"(h) : "v"(src), "n"(N & 3));
    else asm volatile("v_mul_f32_e32 %0, %1, %0" : "+v"(h) : "v"(src));
}

__device__ __forceinline__ void split8(const f32x4 a, const f32x4 b, bf16x8& hi, bf16x8& lo) {
    v4u h; h.x = pg8::cvt_pk_bf16(a[0], a[1]); h.y = pg8::cvt_pk_bf16(a[2], a[3]); h.z = pg8::cvt_pk_bf16(b[0], b[1]); h.w = pg8::cvt_pk_bf16(b[2], b[3]);
    v4u l; l.x = pg8::cvt_pk_bf16(a[0] - bflo(h.x), a[1] - bfhi(h.x)); l.y = pg8::cvt_pk_bf16(a[2] - bflo(h.y), a[3] - bfhi(h.y));
    l.z = pg8::cvt_pk_bf16(b[0] - bflo(h.z), b[1] - bfhi(h.z)); l.w = pg8::cvt_pk_bf16(b[2] - bflo(h.w), b[3] - bfhi(h.w));
    hi = __builtin_bit_cast(bf16x8, h); lo = __builtin_bit_cast(bf16x8, l);
}
__device__ __forceinline__ void phase_p4_chain(unsigned char* ws, LAS unsigned char* lds, int bh, int wave, int lane) {
    const float* MN = (const float*)(ws + WS_MN); float* HC = (float*)(ws + WS_HC);
    LAS float* Hs = (LAS float*)lds;
    const int rt = wave >> 1, c0 = 2 * (wave & 1), ql = lane & 15, g = lane >> 4;
    for (int i = threadIdx.x; i < 64 * 68; i += NTHR) Hs[i] = 0.f;
    const float* mbase = MN + ((size_t)(bh * NCH) * 2) * 4096;
    const float* mrow = mbase + (16 * rt + ql) * 64 + 8 * g;
    const float* nrow = mbase + 4096 + (16 * c0 + ql) * 64 + 16 * rt + 4 * g;
    {
        float* snap = HC + (size_t)(bh * NCH) * 4096;
        for (int i = threadIdx.x; i < 1024; i += NTHR) *(f32x4*)(snap + 4 * i) = (f32x4){0.f, 0.f, 0.f, 0.f};
    }
    __syncthreads();
    struct CSet { f32x4 m00, m01, m10, m11, n0, n1; };
#define CH_LOAD(S, c_) do { const size_t o = (size_t)(((c_) < NCH - 1) ? (c_) : (NCH - 2)) * 8192; \
        S.m00 = *(const f32x4*)(mrow + o); S.m01 = *(const f32x4*)(mrow + o + 4); S.m10 = *(const f32x4*)(mrow + o + 32); S.m11 = *(const f32x4*)(mrow + o + 36); \
        S.n0 = *(const f32x4*)(nrow + o); S.n1 = *(const f32x4*)(nrow + o + 1024); } while (0)
#define CH_STEP(S, c_) do { \
        bf16x8 ah[2], al[2]; split8(S.m00, S.m01, ah[0], al[0]); split8(S.m10, S.m11, ah[1], al[1]); \
        f32x4 acc[2] = {S.n0, S.n1}; \
        _Pragma("unroll") for (int ci = 0; ci < 2; ++ci) { const LAS float* hcol = Hs + (16 * (c0 + ci) + ql) * 68 + 8 * g; \
            _Pragma("unroll") for (int sI = 0; sI < 2; ++sI) { bf16x8 bh_, bl_; \
                split8(*(const LAS f32x4*)(hcol + 32 * sI), *(const LAS f32x4*)(hcol + 32 * sI + 4), bh_, bl_); \
                acc[ci] = __builtin_amdgcn_mfma_f32_16x16x32_bf16(ah[sI], bh_, acc[ci], 0, 0, 0); \
                acc[ci] = __builtin_amdgcn_mfma_f32_16x16x32_bf16(al[sI], bh_, acc[ci], 0, 0, 0); \
                acc[ci] = __builtin_amdgcn_mfma_f32_16x16x32_bf16(ah[sI], bl_, acc[ci], 0, 0, 0); } } \
        __syncthreads(); \
        float* snap = HC + (size_t)(bh * NCH + (c_) + 1) * 4096; \
        _Pragma("unroll") for (int ci = 0; ci < 2; ++ci) { const int col = 16 * (c0 + ci) + ql; \
            *(LAS f32x4*)(Hs + col * 68 + 16 * rt + 4 * g) = acc[ci]; *(f32x4*)(snap + col * 64 + 16 * rt + 4 * g) = acc[ci]; } \
        __syncthreads(); } while (0)
    CSet s0, s1, s2, s3, s4, s5;
    CH_LOAD(s0, 0); CH_LOAD(s1, 1); CH_LOAD(s2, 2); CH_LOAD(s3, 3); CH_LOAD(s4, 4);
    for (int c = 0; c < NCH - 1; c += 6) {
        CH_LOAD(s5, c + 5); CH_STEP(s0, c);
        if (c + 1 < NCH - 1) { CH_LOAD(s0, c + 6); CH_STEP(s1, c + 1); }
        if (c + 2 < NCH - 1) { CH_LOAD(s1, c + 7); CH_STEP(s2, c + 2); }
        if (c + 3 < NCH - 1) { CH_LOAD(s2, c + 8); CH_STEP(s3, c + 3); }
        if (c + 4 < NCH - 1) { CH_LOAD(s3, c + 9); CH_STEP(s4, c + 4); }
        if (c + 5 < NCH - 1) { CH_LOAD(s4, c + 10); CH_STEP(s5, c + 5); }
    }
#undef CH_LOAD
#undef CH_STEP
}

__device__ __forceinline__ void attn_unit(unsigned char* ws, LAS unsigned char* lds, int bh, int j, bool own, int tid, int wave, int lane) {
    const bf16* QR = (const bf16*)(ws + WS_QR); const bf16* KR = (const bf16*)(ws + WS_KR); const bf16* VR = (const bf16*)(ws + WS_VR);
    const unsigned* SEL = (const unsigned*)(ws + WS_SEL);
    bf16* PO = (bf16*)(ws + WS_PO); float* PM = (float*)(ws + WS_PM); float* PL = (float*)(ws + WS_PL);
    LAS unsigned char* KS = lds; LAS unsigned char* VS = lds + 32768;
    LAS unsigned short* LIST = (LAS unsigned short*)(lds + 65536); LAS unsigned* CNT = (LAS unsigned*)(lds + 65536 + 32768);
    const int b = bh >> 3, h = bh & 7;
    __syncthreads();
    if (tid == 0) *CNT = 0u;
    {
        const bf16* Kg = KR + ((size_t)bh * SEQ + j * 256) * 64; const bf16* Vg = VR + ((size_t)bh * SEQ + j * 256) * 64;
#pragma unroll
        for (int i = 0; i < 4; ++i) {
            const int q = tid + 512 * i, key = q >> 3, c = q & 7;
            const v4u kv = *(const v4u*)(Kg + key * 64 + c * 8);
            *(LAS v4u*)(KS + key * 128 + ((c ^ ((key >> 1) & 7)) << 4)) = kv;
            const v4u vv = *(const v4u*)(Vg + key * 64 + c * 8);
            const int pos = (key & ~31) + 8 * ((key >> 2) & 3) + 4 * ((key >> 4) & 1) + (key & 3), cc = pos >> 3, pw = (pos & 7) * 2;
            const unsigned wv[4] = {vv.x, vv.y, vv.z, vv.w};
#pragma unroll
            for (int e = 0; e < 8; ++e) { const int d = c * 8 + e; const unsigned short val = (unsigned short)((e & 1) ? (wv[e >> 1] >> 16) : (wv[e >> 1] & 0xffffu));
                *(LAS unsigned short*)(VS + d * 512 + ((cc ^ (d & 15)) << 4) + pw) = val; }
        }
    }
    __syncthreads();
    int cnt = 256;
    if (!own) {
        for (int tt = (j + 1) * 256; tt < SEQ; tt += 2048) {
            unsigned wq[4];
#pragma unroll
            for (int q = 0; q < 4; ++q) { const int tl = tt + 512 * q + tid; wq[q] = (tl < SEQ) ? SEL[(size_t)(b * SEQ + tl) * 8 + h] : 0xffffffffu; }
#pragma unroll
            for (int q = 0; q < 4; ++q) {
                const int tl = tt + 512 * q + tid; const unsigned w = wq[q];
                const int n = ((w & 0xffu) == (unsigned)j) ? 0 : (((w >> 8) & 0xffu) == (unsigned)j) ? 1 : (((w >> 16) & 0xffu) == (unsigned)j) ? 2 : -1;
                const unsigned long long mk = __ballot(n >= 0);
                const int np = __popcll(mk);
                unsigned base = 0u;
                if (lane == 0 && np) base = lds_add(CNT, (unsigned)np);
                base = __shfl(base, 0);
                if (n >= 0) { const int rk = __popcll(mk & ((1ull << lane) - 1ull)); LIST[base + rk] = (unsigned short)((tl << 2) | n); }
            }
        }
        __syncthreads();
        cnt = (int)*CNT;
    }
    const int nitems = (cnt + 15) >> 4, ql = lane & 15, g = lane >> 4;
#define ATT_ITEM(r_) (own ? ((r_) >= 2 ? -1 : ((r_) ? 15 - wave : wave)) : ((wave + 8 * (r_) < nitems) ? wave + 8 * (r_) : -1))
#define ATT_FETCH(it_, entry_, valid_, q0_, q1_) do { const int e_ = (it_) * 16 + ql; valid_ = e_ < cnt; \
        if (own) entry_ = (unsigned)(((j * 256 + e_) << 2) | 3); else entry_ = LIST[valid_ ? e_ : (it_) * 16]; \
        const bf16* qrow_ = QR + ((size_t)bh * SEQ + (int)(entry_ >> 2)) * 64; q0_ = *(const bf16x8*)(qrow_ + 8 * g); q1_ = *(const bf16x8*)(qrow_ + 32 + 8 * g); } while (0)
    int itn = ATT_ITEM(0); unsigned entn = 0u; bool validn = false; bf16x8 qn0 = {}, qn1 = {};
    if (itn >= 0) ATT_FETCH(itn, entn, validn, qn0, qn1);
    for (int r = 0; itn >= 0; ++r) {
        const int it = itn; const unsigned entry = entn; const bool valid = validn; const bf16x8 qf0 = qn0, qf1 = qn1;
        itn = ATT_ITEM(r + 1);
        if (itn >= 0) ATT_FETCH(itn, entn, validn, qn0, qn1);
        const int tl = (int)(entry >> 2), slot = (int)(entry & 3u);
        const int ntile = own ? it + 1 : 16;
        f32x4 sc[16];
#pragma unroll
        for (int n2 = 0; n2 < 16; ++n2) {
            if (n2 < ntile) {
                const int key = 16 * n2 + ql, sw = (key >> 1) & 7;
                const bf16x8 a0 = *(const LAS bf16x8*)(KS + key * 128 + ((g ^ sw) << 4)), a1 = *(const LAS bf16x8*)(KS + key * 128 + (((4 + g) ^ sw) << 4));
                f32x4 a = __builtin_amdgcn_mfma_f32_16x16x32_bf16(a0, qf0, (f32x4){0.f, 0.f, 0.f, 0.f}, 0, 0, 0);
                sc[n2] = __builtin_amdgcn_mfma_f32_16x16x32_bf16(a1, qf1, a, 0, 0, 0);
            } else sc[n2] = (f32x4){-__builtin_inff(), -__builtin_inff(), -__builtin_inff(), -__builtin_inff()};
        }
        if (own) {
#pragma unroll
            for (int n2 = 0; n2 < 16; ++n2) if (n2 == it) {
#pragma unroll
                for (int rg = 0; rg < 4; ++rg) if (4 * g + rg > ql) sc[n2][rg] = -__builtin_inff();
            }
        }
        float mx = -__builtin_inff();
#pragma unroll
        for (int n2 = 0; n2 < 16; ++n2) mx = fmaxf(mx, fmaxf(fmaxf(sc[n2][0], sc[n2][1]), fmaxf(sc[n2][2], sc[n2][3])));
        mx = fmaxf(mx, __shfl_xor(mx, 16)); mx = fmaxf(mx, __shfl_xor(mx, 32));
        float ls = 0.f;
#pragma unroll
        for (int n2 = 0; n2 < 16; ++n2) {
#pragma unroll
            for (int rg = 0; rg < 4; ++rg) { const float p = __expf(sc[n2][rg] - mx); sc[n2][rg] = p; ls += p; }
        }
        ls += __shfl_xor(ls, 16); ls += __shfl_xor(ls, 32);
        f32x4 o[4];
#pragma unroll
        for (int dt = 0; dt < 4; ++dt) o[dt] = (f32x4){0.f, 0.f, 0.f, 0.f};
#pragma unroll
        for (int s2 = 0; s2 < 8; ++s2) {
            if (2 * s2 < ntile) {
                v4u pw; pw.x = pg8::cvt_pk_bf16(sc[2 * s2][0], sc[2 * s2][1]); pw.y = pg8::cvt_pk_bf16(sc[2 * s2][2], sc[2 * s2][3]);
                pw.z = pg8::cvt_pk_bf16(sc[2 * s2 + 1][0], sc[2 * s2 + 1][1]); pw.w = pg8::cvt_pk_bf16(sc[2 * s2 + 1][2], sc[2 * s2 + 1][3]);
                const bf16x8 pf = __builtin_bit_cast(bf16x8, pw);
#pragma unroll
                for (int dt = 0; dt < 4; ++dt) { const int d = 16 * dt + ql;
                    const bf16x8 va = *(const LAS bf16x8*)(VS + d * 512 + (((4 * s2 + g) ^ (d & 15)) << 4));
                    o[dt] = __builtin_amdgcn_mfma_f32_16x16x32_bf16(va, pf, o[dt], 0, 0, 0); }
            }
        }
        if (valid) {
            const float inv = 1.0f / ls;
            const size_t pair = ((size_t)(b * SEQ + tl) * 8 + h) * 4 + slot;
#pragma unroll
            for (int dt = 0; dt < 4; ++dt) { v2u w; w.x = pg8::cvt_pk_bf16(o[dt][0] * inv, o[dt][1] * inv); w.y = pg8::cvt_pk_bf16(o[dt][2] * inv, o[dt][3] * inv);
                *(v2u*)(PO + pair * 64 + 16 * dt + 4 * g) = w; }
            if (g == 0) { PM[pair] = mx; PL[pair] = ls; }
        }
    }
}

__device__ __forceinline__ void phase_p5_merge(unsigned char* ws, int gw, int NGW, int lane) {
    const unsigned* SEL = (const unsigned*)(ws + WS_SEL); const bf16* PO = (const bf16*)(ws + WS_PO); const float* PM = (const float*)(ws + WS_PM); const float* PL = (const float*)(ws + WS_PL);
    bf16* YB = (bf16*)(ws + WS_YB);
    const int h = lane >> 3, part = lane & 7;
    for (int t0 = gw * 4; t0 < T; t0 += NGW * 4) {
        unsigned w[4]; float m0[4], m1[4], m2[4], m3[4], l0[4], l1[4], l2[4], l3[4]; bool v0[4], v1[4], v2[4];
#pragma unroll
        for (int q = 0; q < 4; ++q) { w[q] = SEL[(size_t)(t0 + q) * 8 + h]; v0[q] = (w[q] & 0xffu) != 255u; v1[q] = ((w[q] >> 8) & 0xffu) != 255u; v2[q] = ((w[q] >> 16) & 0xffu) != 255u;
        }
        const float NI = -__builtin_inff();
#pragma unroll
        for (int q = 0; q < 4; ++q) { const size_t pb = ((size_t)(t0 + q) * 8 + h) * 4;
            const f32x4 pm = *(const f32x4*)(PM + pb), pl = *(const f32x4*)(PL + pb);
            m0[q] = v0[q] ? pm[0] : NI; m1[q] = v1[q] ? pm[1] : NI; m2[q] = v2[q] ? pm[2] : NI; m3[q] = pm[3];
            l0[q] = v0[q] ? pl[0] : 0.f; l1[q] = v1[q] ? pl[1] : 0.f; l2[q] = v2[q] ? pl[2] : 0.f; l3[q] = pl[3]; }
        v4u p0[4], p1[4], p2[4], p3[4];
#pragma unroll
        for (int q = 0; q < 4; ++q) { const size_t pb = ((size_t)(t0 + q) * 8 + h) * 4; const v4u z = {0u, 0u, 0u, 0u};
            const v4u r0 = *(const v4u*)(PO + (pb + 0) * 64 + part * 8), r1 = *(const v4u*)(PO + (pb + 1) * 64 + part * 8), r2 = *(const v4u*)(PO + (pb + 2) * 64 + part * 8);
            p0[q] = v0[q] ? r0 : z; p1[q] = v1[q] ? r1 : z; p2[q] = v2[q] ? r2 : z; p3[q] = *(const v4u*)(PO + (pb + 3) * 64 + part * 8); }
#pragma unroll
        for (int q = 0; q < 4; ++q) {
            const float ms = fmaxf(fmaxf(m0[q], m1[q]), fmaxf(m2[q], m3[q]));
            float a0 = v0[q] ? l0[q] * __expf(m0[q] - ms) : 0.f, a1 = v1[q] ? l1[q] * __expf(m1[q] - ms) : 0.f, a2 = v2[q] ? l2[q] * __expf(m2[q] - ms) : 0.f, a3 = l3[q] * __expf(m3[q] - ms);
            const float inv = 1.0f / (((a0 + a1) + a2) + a3); a0 *= inv; a1 *= inv; a2 *= inv; a3 *= inv;
            float acc[8];
#define MRG(e, f, c_) acc[e] = a0 * f(p0[q].c_) + a1 * f(p1[q].c_) + a2 * f(p2[q].c_) + a3 * f(p3[q].c_)
            MRG(0, bflo, x); MRG(1, bfhi, x); MRG(2, bflo, y); MRG(3, bfhi, y); MRG(4, bflo, z); MRG(5, bfhi, z); MRG(6, bflo, w); MRG(7, bfhi, w);
#undef MRG
            v4u o; o.x = pk2(acc[0], acc[1]); o.y = pk2(acc[2], acc[3]); o.z = pk2(acc[4], acc[5]); o.w = pk2(acc[6], acc[7]);
            *(v4u*)(YB + (size_t)(t0 + q) * 1024 + h * 64 + part * 8) = o;
        }
    }
}


constexpr int WY_WRB = 18432;
constexpr int WY_TA = 0, WY_TB = 2304, WY_TK = 4608, WY_TR = 6912;
constexpr int WY_CB = 9216, WY_CK = 11264, WY_VT = 13312;
constexpr int WY_PK = 15360, WY_PRB = 15872, WY_PRK = 16384;
constexpr int WY_GC = 16896, WY_BON = 17152;

__device__ __forceinline__ bf16x8 frag_lo(v2u lo) { v4u w; w.x = lo.x; w.y = lo.y; w.z = 0u; w.w = 0u; return __builtin_bit_cast(bf16x8, w); }
__device__ __forceinline__ bf16x8 frag_2(v2u a, v2u b) { v4u w; w.x = a.x; w.y = a.y; w.z = b.x; w.w = b.y; return __builtin_bit_cast(bf16x8, w); }
__device__ __forceinline__ v2u pack4(const f32x4 v) { v2u w; w.x = pg8::cvt_pk_bf16(v[0], v[1]); w.y = pg8::cvt_pk_bf16(v[2], v[3]); return w; }
#define WY_MFMA(a, b, c) __builtin_amdgcn_mfma_f32_16x16x32_bf16(a, b, c, 0, 0, 0)

template <bool WITHV, bool WITHY>
__device__ __forceinline__ void wy_prep(LAS unsigned char* wl, const float* PRE, const float* PREV, int t0, int h, int lane, float rk, float kkc, float kac) {
    asm volatile("" : "+v"(lane));
    float kkv[16], wv[16], bv[16], kpv[16], rv[16], vt[16];
    const float* pre0 = PRE + ((size_t)t0 * 8 + h) * 320; const float* pv0 = PREV + (size_t)t0 * 512 + h * 64;
    const unsigned ul = (unsigned)lane;
#pragma unroll
    for (int t = 0; t < 16; ++t) { kkv[t] = (pre0 + (t * 2560 + 192))[ul]; wv[t] = (pre0 + (t * 2560 + 64))[ul]; bv[t] = (pre0 + (t * 2560 + 128))[ul];
        if (WITHV) vt[t] = (pv0 + t * 512)[ul];
        if (WITHY) rv[t] = (pre0 + (t * 2560 + 256))[ul]; }
    {
        float n2[16], q8[8], q4[4], q2[2], q1;
#pragma unroll
        for (int t = 0; t < 16; ++t) { const float x = kkv[t] * kkc; n2[t] = x * x; }
        { const bool hi = (lane & 32) != 0;
#pragma unroll
          for (int i = 0; i < 8; ++i) { const float keep = hi ? n2[i + 8] : n2[i], send = hi ? n2[i] : n2[i + 8]; q8[i] = keep + __shfl_xor(send, 32); } }
        { const bool hi = (lane & 16) != 0;
#pragma unroll
          for (int i = 0; i < 4; ++i) { const float keep = hi ? q8[i + 4] : q8[i], send = hi ? q8[i] : q8[i + 4]; q4[i] = keep + __shfl_xor(send, 16); } }
        { const bool hi = (lane & 8) != 0;
#pragma unroll
          for (int i = 0; i < 2; ++i) { const float keep = hi ? q4[i + 2] : q4[i], send = hi ? q4[i] : q4[i + 2]; q2[i] = keep + __shfl_xor(send, 8); } }
        { const bool hi = (lane & 4) != 0; const float keep = hi ? q2[1] : q2[0], send = hi ? q2[0] : q2[1]; q1 = keep + __shfl_xor(send, 4); }
        q1 += __shfl_xor(q1, 2); q1 += __shfl_xor(q1, 1);
#pragma unroll
        for (int t = 0; t < 16; ++t) {
            const float nn = __builtin_bit_cast(float, __builtin_amdgcn_readlane(__builtin_bit_cast(int, q1), ((t >> 3) & 1) * 32 + ((t >> 2) & 1) * 16 + ((t >> 1) & 1) * 8 + (t & 1) * 4));
            const float k = kkv[t], a = bv[t];
            const float kk = (k * kkc) / fmaxf(sqrtf(nn), 1e-12f);
            kkv[t] = kk; bv[t] = kk * a; if (WITHV) kpv[t] = k * (1.0f + (a - 1.0f) * kac);
        }
    }
    float gam = 1.f, pb[16];
#pragma unroll
    for (int t = 0; t < 16; ++t) {
        const float gp = gam; gam *= wv[t]; const float ig = __builtin_amdgcn_rcpf(gam);
        if (WITHY) pb[t] = rv[t] * kpv[t] * rk;
        bv[t] *= ig;
        *(LAS unsigned short*)(wl + WY_TA + t * 144 + lane * 2) = (unsigned short)f2bf(-gp * kkv[t]);
        *(LAS unsigned short*)(wl + WY_TB + t * 144 + lane * 2) = (unsigned short)f2bf(bv[t]);
        if (WITHV) { kpv[t] *= ig; *(LAS unsigned short*)(wl + WY_TK + t * 144 + lane * 2) = (unsigned short)f2bf(kpv[t]); }
        if (WITHY) *(LAS unsigned short*)(wl + WY_TR + t * 144 + lane * 2) = (unsigned short)f2bf(gam * rv[t]);
    }
    if (WITHY) {
        float q8[8], q4[4], q2[2], q1;
        { const bool hi = (lane & 32) != 0;
#pragma unroll
          for (int i = 0; i < 8; ++i) { const float keep = hi ? pb[i + 8] : pb[i], send = hi ? pb[i] : pb[i + 8]; q8[i] = keep + __shfl_xor(send, 32); } }
        { const bool hi = (lane & 16) != 0;
#pragma unroll
          for (int i = 0; i < 4; ++i) { const float keep = hi ? q8[i + 4] : q8[i], send = hi ? q8[i] : q8[i + 4]; q4[i] = keep + __shfl_xor(send, 16); } }
        { const bool hi = (lane & 8) != 0;
#pragma unroll
          for (int i = 0; i < 2; ++i) { const float keep = hi ? q4[i + 2] : q4[i], send = hi ? q4[i] : q4[i + 2]; q2[i] = keep + __shfl_xor(send, 8); } }
        { const bool hi = (lane & 4) != 0; const float keep = hi ? q2[1] : q2[0], send = hi ? q2[0] : q2[1]; q1 = keep + __shfl_xor(send, 4); }
        q1 += __shfl_xor(q1, 2); q1 += __shfl_xor(q1, 1);
        const int tk = ((lane >> 5) & 1) * 8 + ((lane >> 4) & 1) * 4 + ((lane >> 3) & 1) * 2 + ((lane >> 2) & 1);
        if ((lane & 3) == 0) *(LAS float*)(wl + WY_BON + tk * 4) = q1;
    }
    *(LAS float*)(wl + WY_GC + lane * 4) = gam;
    v4u o0, o1;
    o0.x = pk2(bv[0] * gam, bv[1] * gam); o0.y = pk2(bv[2] * gam, bv[3] * gam); o0.z = pk2(bv[4] * gam, bv[5] * gam); o0.w = pk2(bv[6] * gam, bv[7] * gam);
    o1.x = pk2(bv[8] * gam, bv[9] * gam); o1.y = pk2(bv[10] * gam, bv[11] * gam); o1.z = pk2(bv[12] * gam, bv[13] * gam); o1.w = pk2(bv[14] * gam, bv[15] * gam);
    *(LAS v4u*)(wl + WY_CB + lane * 32) = o0; *(LAS v4u*)(wl + WY_CB + lane * 32 + 16) = o1;
    if (WITHV) {
        o0.x = pk2(kpv[0] * gam, kpv[1] * gam); o0.y = pk2(kpv[2] * gam, kpv[3] * gam); o0.z = pk2(kpv[4] * gam, kpv[5] * gam); o0.w = pk2(kpv[6] * gam, kpv[7] * gam);
        o1.x = pk2(kpv[8] * gam, kpv[9] * gam); o1.y = pk2(kpv[10] * gam, kpv[11] * gam); o1.z = pk2(kpv[12] * gam, kpv[13] * gam); o1.w = pk2(kpv[14] * gam, kpv[15] * gam);
        *(LAS v4u*)(wl + WY_CK + lane * 32) = o0; *(LAS v4u*)(wl + WY_CK + lane * 32 + 16) = o1;
        o0.x = pk2(vt[0], vt[1]); o0.y = pk2(vt[2], vt[3]); o0.z = pk2(vt[4], vt[5]); o0.w = pk2(vt[6], vt[7]);
        o1.x = pk2(vt[8], vt[9]); o1.y = pk2(vt[10], vt[11]); o1.z = pk2(vt[12], vt[13]); o1.w = pk2(vt[14], vt[15]);
        *(LAS v4u*)(wl + WY_VT + lane * 32) = o0; *(LAS v4u*)(wl + WY_VT + lane * 32 + 16) = o1;
    }
    LDS_WAIT(); asm volatile("" ::: "memory");
}
__device__ __forceinline__ bf16x8 wy_nat(const LAS unsigned char* img, int ql, int g, int s) { return *(const LAS bf16x8*)(img + ql * 144 + 64 * s + 16 * g); }
__device__ __forceinline__ bf16x8 wy_perm(const LAS unsigned char* img, int ql, int g, int s) {
    return frag_2(*(const LAS v2u*)(img + ql * 144 + 64 * s + 8 * g), *(const LAS v2u*)(img + ql * 144 + 64 * s + 32 + 8 * g)); }
__device__ __forceinline__ bf16x8 wy_tok4(const LAS unsigned char* img, int row, int g) { return frag_lo(*(const LAS v2u*)(img + row * 32 + 8 * g)); }
template <int I> __device__ __forceinline__ void wy_solve(float (&z)[4][4], const float (&pab)[4], int ql) {
    if constexpr (I < 15) {
        float u[4];
#pragma unroll
        for (int ct = 0; ct < 4; ++ct) u[ct] = __shfl(z[ct][I & 3], ql + 16 * (I >> 2));
        asm volatile("s_nop 1");
#pragma unroll
        for (int ct = 0; ct < 4; ++ct) {
            fmac_bc<I>(z[ct][0], pab[0], u[ct]); fmac_bc<I>(z[ct][1], pab[1], u[ct]); fmac_bc<I>(z[ct][2], pab[2], u[ct]); fmac_bc<I>(z[ct][3], pab[3], u[ct]); }
        wy_solve<I + 1>(z, pab, ql);
    }
}
template <bool WITHV, bool WITHY>
__device__ __forceinline__ void wy_block(f32x4 (&acc)[4][4], f32x4 (&y)[4], LAS unsigned char* wl, int lane) {
    asm volatile("" : "+v"(lane));
    const int ql = lane & 15, g = lane >> 4;
    const f32x4 zero4 = {0.f, 0.f, 0.f, 0.f};
    f32x4 pab = zero4;
    {
        const bf16x8 a0 = wy_nat(wl + WY_TA, ql, g, 0), a1 = wy_nat(wl + WY_TA, ql, g, 1), b0 = wy_nat(wl + WY_TB, ql, g, 0), b1 = wy_nat(wl + WY_TB, ql, g, 1);
        pab = WY_MFMA(a0, b0, pab); pab = WY_MFMA(a1, b1, pab);
#pragma unroll
        for (int r = 0; r < 4; ++r) pab[r] = (4 * g + r > ql) ? pab[r] : 0.f;
        if (WITHV) {
            const bf16x8 k0 = wy_nat(wl + WY_TK, ql, g, 0), k1 = wy_nat(wl + WY_TK, ql, g, 1);
            f32x4 p = WY_MFMA(a0, k0, zero4); p = WY_MFMA(a1, k1, p);
#pragma unroll
            for (int r = 0; r < 4; ++r) *(LAS unsigned short*)(wl + WY_PK + (4 * g + r) * 32 + ql * 2) = (unsigned short)f2bf((4 * g + r > ql) ? p[r] : 0.f);
            if (WITHY) {
                const bf16x8 r0 = wy_nat(wl + WY_TR, ql, g, 0), r1 = wy_nat(wl + WY_TR, ql, g, 1);
                f32x4 q = WY_MFMA(r0, b0, zero4); q = WY_MFMA(r1, b1, q);
#pragma unroll
                for (int r = 0; r < 4; ++r) *(LAS unsigned short*)(wl + WY_PRB + (4 * g + r) * 32 + ql * 2) = (unsigned short)f2bf((4 * g + r >= ql) ? q[r] : 0.f);
                q = WY_MFMA(r0, k0, zero4); q = WY_MFMA(r1, k1, q);
#pragma unroll
                for (int r = 0; r < 4; ++r) *(LAS unsigned short*)(wl + WY_PRK + (4 * g + r) * 32 + ql * 2) = (unsigned short)f2bf((4 * g + r >= ql) ? q[r] : 0.f);
            }
        }
    }
    bf16x8 hf[2][4];
#pragma unroll
    for (int s = 0; s < 2; ++s)
#pragma unroll
        for (int ct = 0; ct < 4; ++ct) hf[s][ct] = frag_2(pack4(acc[2 * s][ct]), pack4(acc[2 * s + 1][ct]));
    LDS_WAIT(); asm volatile("" ::: "memory");
    f32x4 z[4];
    bf16x8 vf[4];
    {
        const bf16x8 a0 = wy_perm(wl + WY_TA, ql, g, 0), a1 = wy_perm(wl + WY_TA, ql, g, 1);
#pragma unroll
        for (int ct = 0; ct < 4; ++ct) { z[ct] = WY_MFMA(a0, hf[0][ct], zero4); z[ct] = WY_MFMA(a1, hf[1][ct], z[ct]); }
        if (WITHV) {
            const bf16x8 pk = wy_tok4(wl + WY_PK, ql, g);
#pragma unroll
            for (int ct = 0; ct < 4; ++ct) { vf[ct] = wy_tok4(wl + WY_VT, 16 * ct + ql, g); z[ct] = WY_MFMA(pk, vf[ct], z[ct]); }
        }
    }
    bf16x8 uf[4];
    {
        float zf[4][4], pf[4];
#pragma unroll
        for (int ct = 0; ct < 4; ++ct)
#pragma unroll
            for (int r = 0; r < 4; ++r) zf[ct][r] = z[ct][r];
#pragma unroll
        for (int r = 0; r < 4; ++r) pf[r] = pab[r];
        wy_solve<0>(zf, pf, ql);
#pragma unroll
        for (int ct = 0; ct < 4; ++ct) { v2u w; w.x = pg8::cvt_pk_bf16(zf[ct][0], zf[ct][1]); w.y = pg8::cvt_pk_bf16(zf[ct][2], zf[ct][3]); uf[ct] = frag_lo(w); }
    }
    if (WITHY) {
        const bf16x8 r0 = wy_perm(wl + WY_TR, ql, g, 0), r1 = wy_perm(wl + WY_TR, ql, g, 1), prb = wy_tok4(wl + WY_PRB, ql, g), prk = wy_tok4(wl + WY_PRK, ql, g);
#pragma unroll
        for (int ct = 0; ct < 4; ++ct) { y[ct] = WY_MFMA(r0, hf[0][ct], zero4); y[ct] = WY_MFMA(r1, hf[1][ct], y[ct]); y[ct] = WY_MFMA(prb, uf[ct], y[ct]); y[ct] = WY_MFMA(prk, vf[ct], y[ct]); }
    }
#pragma unroll
    for (int rt = 0; rt < 4; ++rt) {
        const f32x4 gc = *(const LAS f32x4*)(wl + WY_GC + (16 * rt + 4 * g) * 4);
        const bf16x8 bb = wy_tok4(wl + WY_CB, 16 * rt + ql, g);
        bf16x8 kb; if (WITHV) kb = wy_tok4(wl + WY_CK, 16 * rt + ql, g);
#pragma unroll
        for (int ct = 0; ct < 4; ++ct) { f32x4 a = acc[rt][ct] * gc; a = WY_MFMA(bb, uf[ct], a); if (WITHV) a = WY_MFMA(kb, vf[ct], a); acc[rt][ct] = a; }
    }
}

template <bool TYPE1>
__device__ __forceinline__ void wy_summary(unsigned char* ws, float* MN, const float* PREV, LAS unsigned char* wl, int bh, int ch, int lane, const float* k_k, const float* k_a) {
    const float* PRE = (const float*)(ws + WS_PRE);
    const float kkc = k_k[(bh & 7) * 64 + lane], kac = k_a[(bh & 7) * 64 + lane];
    const int ql = lane & 15, g = lane >> 4, b = bh >> 3, h = bh & 7, t0 = b * SEQ + ch * RCH;
    f32x4 acc[4][4], y[4];
#pragma unroll
    for (int rt = 0; rt < 4; ++rt)
#pragma unroll
        for (int ct = 0; ct < 4; ++ct)
#pragma unroll
            for (int r = 0; r < 4; ++r) acc[rt][ct][r] = (!TYPE1 && rt == ct && (4 * g + r == ql)) ? 1.f : 0.f;
    for (int blk = 0; blk < RCH / 16; ++blk) { wy_prep<TYPE1, false>(wl, PRE, PREV, t0 + 16 * blk, h, lane, 0.f, kkc, kac); wy_block<TYPE1, false>(acc, y, wl, lane); }
    float* dst = MN + ((size_t)(bh * NCH + ch) * 2 + (TYPE1 ? 1 : 0)) * 4096 + (TYPE1 ? (ql * 64 + 4 * g) : (4 * g * 64 + ql));
    asm volatile("" : "+v"(dst));
#pragma unroll
    for (int rt = 0; rt < 4; ++rt)
#pragma unroll
        for (int ct = 0; ct < 4; ++ct) {
            if (TYPE1) *(f32x4*)(dst + (16 * ct) * 64 + 16 * rt) = acc[rt][ct];
            else {
#pragma unroll
                for (int r = 0; r < 4; ++r) dst[(16 * rt + r) * 64 + 16 * ct] = acc[rt][ct][r];
            }
        }
}
__device__ __forceinline__ void phase_p3_wy(unsigned char* ws, float* MN, const float* PREV, const float* k_k, const float* k_a, LAS unsigned char* lds, int gw, int NGW, int wave, int lane) {
    LAS unsigned char* wl = lds + wave * WY_WRB;
    for (int it = gw; it < 16 * NCH * 2; it += NGW) {
        const int type = __builtin_amdgcn_readfirstlane(it & 1), ch = __builtin_amdgcn_readfirstlane((it >> 1) & (NCH - 1)), bh = __builtin_amdgcn_readfirstlane(it >> 8);
        if (type) wy_summary<true>(ws, MN, PREV, wl, bh, ch, lane, k_k, k_a); else wy_summary<false>(ws, MN, PREV, wl, bh, ch, lane, k_k, k_a);
    }
}
__device__ __forceinline__ void phase_p5_rwkv_wy(unsigned char* ws, const float* PREV, const float* G, const float* r_k, const float* lnx_g, const float* lnx_b, const float* k_k, const float* k_a, LAS unsigned char* lds, int gw, int NGW, int wave, int lane) {
    const float* PRE = (const float*)(ws + WS_PRE); const float* HC = (const float*)(ws + WS_HC); bf16* YB = (bf16*)(ws + WS_YB);
    LAS unsigned char* wl = lds + wave * WY_WRB;
    const int ql = lane & 15, g = lane >> 4;
    for (int it = gw; it < 16 * NCH; it += NGW) {
        const int ch = __builtin_amdgcn_readfirstlane(it & (NCH - 1)), bh = __builtin_amdgcn_readfirstlane(it >> 7), b = bh >> 3, h = bh & 7;
        const int t0 = b * SEQ + ch * RCH;
        f32x4 acc[4][4], y[4];
        const float* src = HC + (size_t)(bh * NCH + ch) * 4096 + ql * 64 + 4 * g;
        asm volatile("" : "+v"(src));
#pragma unroll
        for (int rt = 0; rt < 4; ++rt)
#pragma unroll
            for (int ct = 0; ct < 4; ++ct) acc[rt][ct] = *(const f32x4*)(src + (16 * ct) * 64 + 16 * rt);
        const float rk = r_k[h * 64 + lane], kkc = k_k[h * 64 + lane], kac = k_a[h * 64 + lane];
        float lg[4], lb[4];
#pragma unroll
        for (int ct = 0; ct < 4; ++ct) { lg[ct] = lnx_g[h * 64 + 16 * ct + ql]; lb[ct] = lnx_b[h * 64 + 16 * ct + ql]; }
        for (int blk = 0; blk < RCH / 16; ++blk) {
            const int tb = t0 + 16 * blk;
            wy_prep<true, true>(wl, PRE, PREV, tb, h, lane, rk, kkc, kac);
            float vv[4][4], gg[4][4];
            {
                const float* pvb = PREV + (size_t)tb * 512 + h * 64; const float* pgb = G + (size_t)tb * 512 + h * 64;
                const unsigned eo = (unsigned)(4 * g * 512 + ql);
#pragma unroll
                for (int r = 0; r < 4; ++r)
#pragma unroll
                    for (int ct = 0; ct < 4; ++ct) { vv[r][ct] = (pvb + (r * 512 + 16 * ct))[eo]; gg[r][ct] = (pgb + (r * 512 + 16 * ct))[eo]; }
            }
            wy_block<true, true>(acc, y, wl, lane);
#pragma unroll
            for (int r = 0; r < 4; ++r) {
                float s = (y[0][r] + y[1][r]) + (y[2][r] + y[3][r]);
                s += __shfl_xor(s, 1); s += __shfl_xor(s, 2); s += __shfl_xor(s, 4); s += __shfl_xor(s, 8);
                const float mean = s * (1.0f / 64.0f);
                float d[4], q = 0.f;
#pragma unroll
                for (int ct = 0; ct < 4; ++ct) { d[ct] = y[ct][r] - mean; q += d[ct] * d[ct]; }
                q += __shfl_xor(q, 1); q += __shfl_xor(q, 2); q += __shfl_xor(q, 4); q += __shfl_xor(q, 8);
                const float rstd = rsqrtf(q * (1.0f / 64.0f) + GN_EPS);
                const float bn = *(const LAS float*)(wl + WY_BON + (4 * g + r) * 4);
                bf16* yb = YB + (size_t)tb * 1024 + 512 + h * 64; const unsigned yo = (unsigned)((4 * g + r) * 1024 + ql);
#pragma unroll
                for (int ct = 0; ct < 4; ++ct) (yb + 16 * ct)[yo] = (bf16)f2bf((d[ct] * rstd * lg[ct] + lb[ct] + bn * vv[r][ct]) * gg[r][ct]);
            }
        }
    }
}

constexpr int WRS2 = 2064;
__device__ __forceinline__ void phase_p8(const float* PRE1, const float* ln_g, const float* ln_b, const float* w_router, const float* b_router,
                                         unsigned char* ws, LAS unsigned char* lds, LAS unsigned* hist, int blk, int G, int tid, int wave, int lane, bool count) {
    LAS unsigned char* whi = lds; LAS unsigned char* wlo = lds + 32 * WRS2;
    for (int i0 = 0; i0 < 64; i0 += 16) {
        float wv[16];
#pragma unroll
        for (int i = 0; i < 16; ++i) wv[i] = w_router[tid + NTHR * (i0 + i)];
#pragma unroll
        for (int i = 0; i < 16; ++i) { const int idx = tid + NTHR * (i0 + i); const float w = wv[i]; const unsigned h = f2bf(w); const unsigned l = f2bf(w - bf2f(h));
            const int e = idx & 31, k = idx >> 5; *(LAS unsigned short*)(whi + e * WRS2 + k * 2) = (unsigned short)h; *(LAS unsigned short*)(wlo + e * WRS2 + k * 2) = (unsigned short)l; }
    }
    if (tid < 32) hist[tid] = 0u;
    __syncthreads();
    bf16* HB = (bf16*)(ws + WS_HB); bf16* HBL = (bf16*)(ws + WS_XG); float* STATS = (float*)(ws + WS_STATS); int* TOPE = (int*)(ws + WS_TOPE); float* TOPG = (float*)(ws + WS_TOPG);
    const int ql = lane & 15, g = lane >> 4;
    f32x4 lg4[4], lb4[4];
#pragma unroll
    for (int j = 0; j < 4; ++j) { lg4[j] = *(const f32x4*)(ln_g + 256 * j + 4 * lane); lb4[j] = *(const f32x4*)(ln_b + 256 * j + 4 * lane); }
    for (int tb = (blk * NWAVES + wave) * 16; tb < T; tb += G * NWAVES * 16) {
        for (int q0 = 0; q0 < 16; q0 += 4) {
            f32x4 x[4][4];
#pragma unroll
            for (int q = 0; q < 4; ++q)
#pragma unroll
                for (int j = 0; j < 4; ++j) x[q][j] = *(const f32x4*)(PRE1 + (size_t)(tb + q0 + q) * 1024 + 256 * j + 4 * lane);
#pragma unroll
            for (int q = 0; q < 4; ++q) {
                const int t = tb + q0 + q; float s = 0.f;
#pragma unroll
                for (int j = 0; j < 4; ++j) s += (x[q][j][0] + x[q][j][1]) + (x[q][j][2] + x[q][j][3]);
                const float mean = wave_sum(s) * (1.0f / 1024.0f); float s2 = 0.f;
#pragma unroll
                for (int j = 0; j < 4; ++j) { x[q][j] = x[q][j] - mean; s2 += (x[q][j][0] * x[q][j][0] + x[q][j][1] * x[q][j][1]) + (x[q][j][2] * x[q][j][2] + x[q][j][3] * x[q][j][3]); }
                const float rstd = rsqrtf(wave_sum(s2) * (1.0f / 1024.0f) + LN_EPS);
                if (lane == 0) { STATS[(size_t)t * 2] = mean; STATS[(size_t)t * 2 + 1] = rstd; }
#pragma unroll
                for (int j = 0; j < 4; ++j) { const f32x4 hh = x[q][j] * rstd * lg4[j] + lb4[j];
                    v2u hi; hi.x = pk2(hh[0], hh[1]); hi.y = pk2(hh[2], hh[3]);
                    v2u lo; lo.x = pk2(hh[0] - bflo(hi.x), hh[1] - bfhi(hi.x)); lo.y = pk2(hh[2] - bflo(hi.y), hh[3] - bfhi(hi.y));
                    *(v2u*)(HB + (size_t)t * 1024 + 256 * j + 4 * lane) = hi; *(v2u*)(HBL + (size_t)t * 1024 + 256 * j + 4 * lane) = lo; }
            }
        }
        VM_WAIT();
        f32x4 acc0 = {0.f, 0.f, 0.f, 0.f}, acc1 = acc0;
        const bf16* arow = HB + (size_t)(tb + ql) * 1024 + 8 * g; const bf16* lrow = HBL + (size_t)(tb + ql) * 1024 + 8 * g;
        const LAS unsigned char* b0p = whi + ql * WRS2 + 16 * g; const LAS unsigned char* b1p = whi + (16 + ql) * WRS2 + 16 * g;
#pragma unroll 1
        for (int s0 = 0; s0 < 32; s0 += 8) {
            bf16x8 ah[8], al[8];
#pragma unroll
            for (int i = 0; i < 8; ++i) { ah[i] = *(const bf16x8*)(arow + 32 * (s0 + i)); al[i] = *(const bf16x8*)(lrow + 32 * (s0 + i)); }
#pragma unroll
            for (int i = 0; i < 8; ++i) {
                const int so = 64 * (s0 + i);
                const bf16x8 bh0 = *(const LAS bf16x8*)(b0p + so), bl0 = *(const LAS bf16x8*)(b0p + 32 * WRS2 + so), bh1 = *(const LAS bf16x8*)(b1p + so), bl1 = *(const LAS bf16x8*)(b1p + 32 * WRS2 + so);
                acc0 = __builtin_amdgcn_mfma_f32_16x16x32_bf16(ah[i], bh0, acc0, 0, 0, 0); acc0 = __builtin_amdgcn_mfma_f32_16x16x32_bf16(al[i], bh0, acc0, 0, 0, 0); acc0 = __builtin_amdgcn_mfma_f32_16x16x32_bf16(ah[i], bl0, acc0, 0, 0, 0);
                acc1 = __builtin_amdgcn_mfma_f32_16x16x32_bf16(ah[i], bh1, acc1, 0, 0, 0); acc1 = __builtin_amdgcn_mfma_f32_16x16x32_bf16(al[i], bh1, acc1, 0, 0, 0); acc1 = __builtin_amdgcn_mfma_f32_16x16x32_bf16(ah[i], bl1, acc1, 0, 0, 0);
            }
        }
        const float br0 = b_router[ql], br1 = b_router[16 + ql];
#pragma unroll
        for (int r = 0; r < 4; ++r) {
            float v0 = acc0[r] + br0, v1 = acc1[r] + br1; float tv[4]; int te[4];
#pragma unroll
            for (int rd = 0; rd < 4; ++rd) {
                float bv = (v0 >= v1) ? v0 : v1; int bi = (v0 >= v1) ? ql : 16 + ql;
#pragma unroll
                for (int off = 1; off < 16; off <<= 1) { const float ov = __shfl_xor(bv, off); const int oi = __shfl_xor(bi, off); const bool take = (ov > bv) || (ov == bv && oi < bi); bv = take ? ov : bv; bi = take ? oi : bi; }
                tv[rd] = bv; te[rd] = bi; if (bi == ql) v0 = -__builtin_inff(); if (bi == 16 + ql) v1 = -__builtin_inff();
            }
            const float e1 = __expf(tv[1] - tv[0]), e2 = __expf(tv[2] - tv[0]), e3 = __expf(tv[3] - tv[0]); const float inv = 1.0f / (((1.0f + e1) + e2) + e3);
            const float gsel = ql == 0 ? inv : ql == 1 ? e1 * inv : ql == 2 ? e2 * inv : e3 * inv;
            const int esel = ql == 0 ? te[0] : ql == 1 ? te[1] : ql == 2 ? te[2] : te[3];
            const int t = tb + 4 * g + r;
            if (ql < 4) { TOPE[(size_t)t * 4 + ql] = esel; TOPG[(size_t)t * 4 + ql] = gsel; lds_add(&hist[esel], 1u); }
        }
    }
    __syncthreads();
    if (count && tid < 32 && hist[tid]) atomicAdd((unsigned*)(ws + WS_CTL) + CW_ECNT + tid, hist[tid]);
}

__device__ __forceinline__ void phase_p9(const float* w1, const float* w2, unsigned char* ws, LAS unsigned char* lds, LAS unsigned* sm  , int blk, int G, int gw, int NGW, int tid, int wave, int lane) {
    unsigned* CTL = (unsigned*)(ws + WS_CTL);
    LAS unsigned* pstart = sm; LAS unsigned* lhist = sm + 32; LAS unsigned* lbase = sm + 64; LAS unsigned* slotOf = sm + 96;
    const int* TOPE = (const int*)(ws + WS_TOPE); const float* TOPG = (const float*)(ws + WS_TOPG); int* TOKSLOT = (int*)(ws + WS_TOKSLOT); float* SLOTG = (float*)(ws + WS_SLOTG);
    int* ROWIDX = (int*)(ws + WS_ROWIDX); int* TILEE = (int*)(ws + WS_TILEE);
    if (tid == 0) { unsigned acc = 0u; for (int e = 0; e < 32; ++e) { pstart[e] = acc; acc += ((CTL[CW_ECNT + e] + 255u) >> 8) << 8; }
        if (blk == 0) CTL[CW_NTILES] = acc >> 8; }
    __syncthreads();
    if (blk == 0) {
        for (int pm = tid; pm < NTILE_MAX; pm += NTHR) { const unsigned row = (unsigned)pm * 256u; int e = 0;
#pragma unroll 4
            for (int q = 1; q < 32; ++q) if (row >= pstart[q]) e = q;
            TILEE[pm] = e; }
    }
    for (int chunk = blk; chunk < T / 128; chunk += G) {
        if (tid < 32) lhist[tid] = 0u;
        __syncthreads();
        const int t = chunk * 128 + (tid >> 2), k = tid & 3; const int e = TOPE[(size_t)t * 4 + k];
        const unsigned rank = lds_add(&lhist[e], 1u);
        __syncthreads();
        if (tid < 32) lbase[tid] = lhist[tid] ? atomicAdd(&CTL[CW_ECUR + tid], lhist[tid]) : 0u;
        __syncthreads();
        const unsigned slot = pstart[e] + lbase[e] + rank;
        TOKSLOT[(size_t)t * 4 + k] = (int)slot; SLOTG[slot] = TOPG[(size_t)t * 4 + k]; ROWIDX[slot] = t;
        __syncthreads();
    }
    LAS float* scr = (LAS float*)(lds + wave * 16384);
    bf16* W1T = (bf16*)(ws + WS_W1T); bf16* W2T = (bf16*)(ws + WS_W2T);
    constexpr int I1 = 16 * 64, I2 = 16 * 32;
    REPS(10) for (int it = gw; it < NEXP * (I1 + I2); it += NGW) {
        if (it < NEXP * I1) { const int e = it / I1, r = it % I1; transpose_item<false>(w1 + (size_t)e * 1024 * 2048, 2048, W1T + (size_t)e * 2048 * 1024, 1024, 64 * (r / 64), 32 * (r % 64), 0, scr, lane); }
        else { const int r0 = it - NEXP * I1, e = r0 / I2, r = r0 % I2; transpose_item<false>(w2 + (size_t)e * 1024 * 1024, 1024, W2T + (size_t)e * 1024 * 1024, 1024, 64 * (r / 32), 32 * (r % 32), 0, scr, lane); }
    }
}

__device__ __forceinline__ void phase_final(float* OUT  , float* OUTW, const float* ln1_g, const float* ln1_b, const float* ln2_g, const float* ln2_b, unsigned char* ws, int gw, int NGW, int lane) {
    const float* STATS = (const float*)(ws + WS_STATS); const int* TOKSLOT = (const int*)(ws + WS_TOKSLOT); const bf16* YS = (const bf16*)(ws + WS_YS);
    f32x4 g1[4], b1[4], g2[4], b2[4];
#pragma unroll
    for (int j = 0; j < 4; ++j) { const int col = 256 * j + 4 * lane; g1[j] = *(const f32x4*)(ln1_g + col) * ALPHA; b1[j] = *(const f32x4*)(ln1_b + col) * ALPHA; g2[j] = *(const f32x4*)(ln2_g + col); b2[j] = *(const f32x4*)(ln2_b + col); }
    for (int t0 = gw * 2; t0 < T; t0 += NGW * 2) {
        float mean[2], rstd[2]; int sl[2][4]; f32x4 x[2][4]; v2u ys[2][4][4];
#pragma unroll
        for (int q = 0; q < 2; ++q) { const int t = t0 + q; mean[q] = STATS[(size_t)t * 2]; rstd[q] = STATS[(size_t)t * 2 + 1];
#pragma unroll
            for (int k = 0; k < 4; ++k) sl[q][k] = TOKSLOT[(size_t)t * 4 + k];
#pragma unroll
            for (int j = 0; j < 4; ++j) x[q][j] = *(const f32x4*)(OUT + (size_t)t * 1024 + 256 * j + 4 * lane); }
#pragma unroll
        for (int q = 0; q < 2; ++q)
#pragma unroll
            for (int k = 0; k < 4; ++k)
#pragma unroll
                for (int j = 0; j < 4; ++j) ys[q][k][j] = *(const v2u*)(YS + (size_t)sl[q][k] * 1024 + 256 * j + 4 * lane);
#pragma unroll
        for (int q = 0; q < 2; ++q) {
            const int t = t0 + q; f32x4 z[4]; float s = 0.f;
#pragma unroll
            for (int j = 0; j < 4; ++j) {
                f32x4 h = (x[q][j] - mean[q]) * rstd[q] * g1[j] + b1[j];
                const v2u y0 = ys[q][0][j], y1 = ys[q][1][j], y2 = ys[q][2][j], y3 = ys[q][3][j];
                h[0] += (bflo(y0.x) + bflo(y1.x)) + (bflo(y2.x) + bflo(y3.x)); h[1] += (bfhi(y0.x) + bfhi(y1.x)) + (bfhi(y2.x) + bfhi(y3.x));
                h[2] += (bflo(y0.y) + bflo(y1.y)) + (bflo(y2.y) + bflo(y3.y)); h[3] += (bfhi(y0.y) + bfhi(y1.y)) + (bfhi(y2.y) + bfhi(y3.y));
                z[j] = h; s += (h[0] + h[1]) + (h[2] + h[3]); }
            const float m2 = wave_sum(s) * (1.0f / 1024.0f); float qq = 0.f;
#pragma unroll
            for (int j = 0; j < 4; ++j) { z[j] = z[j] - m2; qq += (z[j][0] * z[j][0] + z[j][1] * z[j][1]) + (z[j][2] * z[j][2] + z[j][3] * z[j][3]); }
            const float r2 = rsqrtf(wave_sum(qq) * (1.0f / 1024.0f) + LN_EPS);
#pragma unroll
            for (int j = 0; j < 4; ++j) *(f32x4*)(OUTW + (size_t)t * 1024 + 256 * j + 4 * lane) = z[j] * r2 * g2[j] + b2[j];
        }
    }
}

#ifndef MK_PER_PHASE
#define MK_PER_PHASE 0
#endif
constexpr int NPHASE = 14;
struct Args { const float* in[26]; float* out; unsigned char* ws; int ph_lo, ph_hi; };

__global__ void __launch_bounds__(NTHR, 2) hybrid_fwd(Args args) {
    extern __shared__ __attribute__((aligned(16))) unsigned char lds_raw[];
    LAS unsigned char* lds = (LAS unsigned char*)lds_raw;
    volatile LAS unsigned* MISC = (volatile LAS unsigned*)(lds + MISC_OFF);
    const int tid = threadIdx.x, lane = tid & 63, wave = __builtin_amdgcn_readfirstlane(tid >> 6);
    const int G = gridDim.x, bx = blockIdx.x;
    const int vcu = (G % 8 == 0) ? (bx % 8) * (G / 8) + bx / 8 : bx;
    const int gw = vcu * NWAVES + wave, NGW = G * NWAVES;
    unsigned char* ws = args.ws;
    unsigned* CTL = (unsigned*)(ws + WS_CTL);
    for (int u = tid; u < (LDS_BYTES - MISC_OFF) / 4; u += NTHR) MISC[u] = 0u;
    __syncthreads();
    XcdBarrier bar; bar.bar = CTL + CW_BAR; bar.x = 0; bar.st = nullptr;
    if (!MK_PER_PHASE) bar = xcd_barrier_post(CTL + CW_BAR, MISC);
    const int lo = args.ph_lo, hi = args.ph_hi;
#ifndef PH_MASK
#define PH_MASK 0x3fff
#endif
#define IN(k) ((((PH_MASK) >> (k)) & 1) && lo <= (k) && (k) < hi)
#define SEAM(k) do { if (IN(k) && IN((k) + 1)) xcd_barrier(bar); } while (0)
#define RSH(k) (((REPEAT_MASK) >> (k)) & 1)
    const float* x = args.in[0];
    float* OUT = args.out;
    float* PREV = OUT;
    float* GG = OUT + (size_t)T * 512;

    if (IN(0)) REPS(0) { phase_p0(x, args.in[1], args.in[13], args.in[14], args.in[15], args.in[4], args.in[6], args.in[7], ws, lds, gw, NGW, wave, lane); }
    SEAM(0);
    if (IN(1)) {
        pg8::Gemm g{(const bf16*)(ws + WS_XB), (const bf16*)(ws + WS_WIN), 1024, 1024, 1024};
        GridOrder S; S.init(T / 256, NPROJ / 256, G, bx, 0u, RSH(1));
        EpiProj E{(bf16*)(ws + WS_QR), (bf16*)(ws + WS_KR), (bf16*)(ws + WS_VR), (bf16*)(ws + WS_SGA), (bf16*)(ws + WS_SGR), (float*)(ws + WS_KMEAN), (const float*)(ws + WS_ROPE),
                  (float*)(ws + WS_PRE), PREV, (float*)(ws + WS_RW), (float*)(ws + WS_RW) + (size_t)(T / 64) * 2048, (bf16*)(ws + WS_APR), args.in[2]};
        pg8::gemm_phase<EpiProj, GridOrder>(lds, g, S, E);
    }
    SEAM(1);
    if (IN(2)) { REPS(2) phase_p2_fix(args.in[2], ws, PREV, gw, NGW, lane); REPS(16) phase_p2_gate(ws, lds, gw, NGW, wave, lane); }
    SEAM(2);
    if (IN(3)) {
        pg8::Gemm g{(const bf16*)(ws + WS_APR), (const bf16*)(ws + WS_WLORA), 256, 512, 256};
        GridOrder S; S.init(T / 256, 6, G, bx, 128u, 0);
        EpiLora E{(float*)(ws + WS_PRE), GG, args.in[3], args.in[5]};
        pg8::gemm_phase<EpiLora, GridOrder>(lds, g, S, E);
    }
    SEAM(3);
    if (IN(4)) REPS(4) { phase_p3_wy(ws, (float*)(ws + WS_MN), PREV, args.in[8], args.in[9], lds, gw, NGW, wave, lane); }
    SEAM(4);
    if (IN(5)) {
        if (bx < 16) REPS(14) phase_p4_chain(ws, lds, bx, wave, lane);
        LAS unsigned* uq = (LAS unsigned*)(lds + 65536 + 32768 + 64);
        REPS(15) {
            unsigned nxt = 0u;
            if (tid == 0) nxt = atomicAdd(CTL + CW_ATTQ + rep, 1u);
            for (;;) {
                __syncthreads();
                if (tid == 0) *uq = nxt;
                __syncthreads();
                const int un = (int)*uq;
                if (un >= 1008 + 1024) break;
                if (tid == 0) nxt = atomicAdd(CTL + CW_ATTQ + rep, 1u);
                if (un < 1008) attn_unit(ws, lds, un & 15, un >> 4, false, tid, wave, lane);
                else attn_unit(ws, lds, (un - 1008) & 15, (un - 1008) >> 4, true, tid, wave, lane);
            }
        }
    }
    SEAM(5);
    if (IN(6)) REPS(6) { phase_p5_merge(ws, gw, NGW, lane);
        phase_p5_rwkv_wy(ws, PREV, GG, args.in[10], args.in[11], args.in[12], args.in[8], args.in[9], lds, gw, NGW, wave, lane); }
    SEAM(6);
    if (IN(7)) {
        pg8::Gemm g{(const bf16*)(ws + WS_YB), (const bf16*)(ws + WS_WBR), 512, 1024, 1024};
        MixOrder S{G, bx, RSH(7)};
        EpiMix E{(bf16*)(ws + WS_MIXED), (const bf16*)(ws + WS_SGA), (const bf16*)(ws + WS_SGR)};
        pg8::gemm_phase<EpiMix, MixOrder>(lds, g, S, E);
    }
    SEAM(7);
    if (IN(8)) {
        pg8::Gemm g{(const bf16*)(ws + WS_MIXED), (const bf16*)(ws + WS_WOUT), 1024, 1024, 1024};
        GridOrder S; S.init(T / 256, 4, G, bx, 0u, RSH(8));
        EpiOut E{OUT, x};
        pg8::gemm_phase<EpiOut, GridOrder>(lds, g, S, E);
    }
    SEAM(8);
    if (IN(9)) REPS(9) { __syncthreads(); phase_p8(OUT, args.in[16], args.in[17], args.in[18], args.in[19], ws, lds, (LAS unsigned*)(lds + MISC_OFF + 256), bx, G, tid, wave, lane, rep == 0); }
    SEAM(9);
    if (IN(10)) { phase_p9(args.in[20], args.in[22], ws, lds, (LAS unsigned*)(lds + MISC_OFF + 512), bx, G, gw, NGW, tid, wave, lane); }
    SEAM(10);
    if (IN(11)) {
        pg8::Gemm g{(const bf16*)(ws + WS_HB), (const bf16*)(ws + WS_W1T), 1024, 1024, 1024, (const int*)(ws + WS_ROWIDX)};
        MoeOrder S{G, bx, 8, (int)__builtin_nontemporal_load(CTL + CW_NTILES), (const int*)(ws + WS_TILEE), 2048u * 1024u * 2u, RSH(11)};
        EpiW1 E{(bf16*)(ws + WS_ACT), args.in[21]};
        pg8::gemm_phase<EpiW1, MoeOrder, true>(lds, g, S, E);
    }
    SEAM(11);
    if (IN(12)) {
        pg8::Gemm g{(const bf16*)(ws + WS_ACT), (const bf16*)(ws + WS_W2T), 1024, 1024, 1024};
        MoeOrder S{G, bx, 4, (int)__builtin_nontemporal_load(CTL + CW_NTILES), (const int*)(ws + WS_TILEE), 1024u * 1024u * 2u, RSH(12)};
        EpiW2 E{(bf16*)(ws + WS_YS), args.in[23], (const float*)(ws + WS_SLOTG)};
        pg8::gemm_phase<EpiW2, MoeOrder>(lds, g, S, E);
    }
    SEAM(12);
    if (IN(13)) REPS(13) { phase_final(OUT, (rep == RSH(13)) ? OUT : (float*)(ws + WS_PRE), args.in[16], args.in[17], args.in[24], args.in[25], ws, gw, NGW, lane); }
#undef IN
#undef SEAM
}

extern "C" void kernel_launch(void* const* d_in, const int* in_sizes, int n_in, void* d_out, int out_size, void* d_ws, size_t ws_size, hipStream_t stream) {
    static int grid = 0;
    if (grid == 0) {
        if (n_in != 26 || out_size != T * D || ws_size < WS_END) { fprintf(stderr, "kernel_launch: unexpected shapes (n_in %d, out %d, ws %zu < %zu)\n", n_in, out_size, ws_size, (size_t)WS_END); grid = -1; return; }
        int dev = 0, cus = 0, per_cu = 0;
        if (hipGetDevice(&dev) != hipSuccess || hipDeviceGetAttribute(&cus, hipDeviceAttributeMultiprocessorCount, dev) != hipSuccess) { grid = -1; return; }
        if (hipFuncSetAttribute((const void*)hybrid_fwd, hipFuncAttributeMaxDynamicSharedMemorySize, LDS_BYTES) != hipSuccess) { fprintf(stderr, "kernel_launch: hipFuncSetAttribute failed\n"); grid = -1; return; }
        if (hipOccupancyMaxActiveBlocksPerMultiprocessor(&per_cu, (const void*)hybrid_fwd, NTHR, LDS_BYTES) != hipSuccess || per_cu < 1) { fprintf(stderr, "kernel_launch: occupancy query says %d blocks/CU\n", per_cu); }
        (void)hipGetLastError();
        grid = cus;
    }
    if (grid < 0) return;
    if (hipMemsetAsync((char*)d_ws + WS_CTL, 0, ZERO_BYTES, stream) != hipSuccess) { fprintf(stderr, "kernel_launch: memset failed\n"); return; }
    Args a{};
    for (int i = 0; i < 26; ++i) a.in[i] = (const float*)d_in[i];
    a.out = (float*)d_out; a.ws = (unsigned char*)d_ws;
#if MK_PER_PHASE
    for (int p = 0; p < NPHASE; ++p) { a.ph_lo = p; a.ph_hi = p + 1; hipLaunchKernelGGL(hybrid_fwd, dim3(grid), dim3(NTHR), LDS_BYTES, stream, a); }
#else
    a.ph_lo = 0; a.ph_hi = NPHASE;
    hipLaunchKernelGGL(hybrid_fwd, dim3(grid), dim3(NTHR), LDS_BYTES, stream, a);
#endif
    const hipError_t le = hipPeekAtLastError();
    if (le != hipSuccess) fprintf(stderr, "kernel_launch: launch failed: %s\n", hipGetErrorName(le));
}
```

```cpp
#include <hip/hip_runtime.h>
#include <cstdio>
#include <cstdint>

#define GAS __attribute__((address_space(1)))
#define LAS __attribute__((address_space(3)))
#define CAS __attribute__((address_space(4)))
typedef unsigned short bf16;
typedef unsigned v4u __attribute__((ext_vector_type(4)));
typedef unsigned v2u __attribute__((ext_vector_type(2)));
typedef float f32x4 __attribute__((ext_vector_type(4)));
typedef float f32x2 __attribute__((ext_vector_type(2)));
typedef short bf16x8 __attribute__((ext_vector_type(8)));
typedef GAS unsigned gu32;
#define RLX_AGENT __ATOMIC_RELAXED, __HIP_MEMORY_SCOPE_AGENT
#define LDS_WAIT() asm volatile("s_waitcnt lgkmcnt(0)" ::: "memory")
#define VM_WAIT() asm volatile("s_waitcnt vmcnt(0)" ::: "memory")

#ifndef REPEAT_MASK
#define REPEAT_MASK 0
#endif
#define REPS(k) for (int rep = 0; rep < 1 + (((REPEAT_MASK) >> (k)) & 1); ++rep)
constexpr int NWAVES = 8, NTHR = 512;
constexpr int T = 32768, D = 1024, SEQ = 16384, NBLK = 64  ;
constexpr int IN_COLS = 5408, NPROJ = 5632  ;
constexpr int OFF_Q = 1824, OFF_AK = 2336, OFF_AV = 2848, OFF_GA = 3360, OFF_GR = 4384, RWC = 1824;
constexpr int NEXP = 32, FF = 1024, NSLOT_MAX = 4 * T + NEXP * 256  , NTILE_MAX = NSLOT_MAX / 256  ;
constexpr int RCH = 128  , NCH = SEQ / RCH  ;
constexpr float LN_EPS = 1e-5f, GN_EPS = 64e-5f, ALPHA = 1.189207115002721f, SW_ALPHA = 1.702f, SW_LIMIT = 7.0f;

constexpr size_t MiB = 1u << 20;
constexpr size_t WS_CTL = 0, ZERO_BYTES = 2 * MiB;
constexpr size_t WS_KMEAN = 1 * MiB;
constexpr size_t WS_ROWIDX = 1 * MiB + 256 * 1024;
constexpr size_t WS_ROPE = 2 * MiB;
constexpr size_t WS_WBR = 6 * MiB, WS_WOUT = 8 * MiB, WS_WLORA = 10 * MiB;
constexpr size_t WS_TILEE = 11 * MiB;
constexpr size_t WS_SEL = 12 * MiB;
constexpr size_t WS_STATS = 13 * MiB;
constexpr size_t WS_TOPE = WS_STATS + 256 * 1024, WS_TOPG = WS_TOPE + 512 * 1024, WS_TOKSLOT = WS_TOPG + 512 * 1024, WS_SLOTG = WS_TOKSLOT + 512 * 1024;
constexpr size_t WS_QR = 16 * MiB, WS_KR = 48 * MiB, WS_VR = 80 * MiB;
constexpr size_t WS_SGA = 112 * MiB, WS_SGR = 176 * MiB;
constexpr size_t WS_XB = 240 * MiB, WS_WIN = 304 * MiB;
constexpr size_t WS_APR = 872 * MiB;
constexpr size_t WS_YB = 240 * MiB;
constexpr size_t WS_RW = 320 * MiB;
constexpr size_t WS_MN = 320 * MiB, WS_HC = 384 * MiB, WS_PO = 416 * MiB, WS_PM = 544 * MiB, WS_PL = 548 * MiB;
constexpr size_t WS_PRE = 552 * MiB;
constexpr size_t WS_MIXED = 872 * MiB;
constexpr size_t WS_W1T = 16 * MiB, WS_W2T = 144 * MiB, WS_HB = 208 * MiB, WS_XG = 272 * MiB, WS_ACT = 544 * MiB, WS_YS = 272 * MiB;
constexpr size_t WS_END = 936 * MiB;
constexpr int CW_TMO = 0, CW_ATTQ = 64, CW_NTILES = 128, CW_ECNT = 192, CW_ECUR = 256, CW_BAR = 4096;

constexpr int RING_BYTES = 131072, MISC_OFF = 147456, LDS_BYTES = 154624;

__device__ __forceinline__ unsigned pk2(float lo, float hi) { unsigned r; asm("v_cvt_pk_bf16_f32 %0, %1, %2" : "=v"(r) : "v"(lo), "v"(hi)); return r; }
__device__ __forceinline__ unsigned f2bf(float f) { return pk2(f, f) & 0xffffu; }
__device__ __forceinline__ float bf2f(unsigned b) { return __builtin_bit_cast(float, b << 16); }
__device__ __forceinline__ float bflo(unsigned w) { return __builtin_bit_cast(float, w << 16); }
__device__ __forceinline__ float bfhi(unsigned w) { return __builtin_bit_cast(float, w & 0xffff0000u); }
__device__ __forceinline__ float wave_sum(float v) {
#pragma unroll
    for (int o = 1; o < 64; o <<= 1) v += __shfl_xor(v, o);
    return v;
}
__device__ __forceinline__ unsigned lds_add(LAS unsigned* p, unsigned v) { return __hip_atomic_fetch_add(p, v, __ATOMIC_RELAXED, __HIP_MEMORY_SCOPE_WORKGROUP); }
__device__ __forceinline__ float sigmoidf_(float x) { return 1.0f / (1.0f + __expf(-x)); }

namespace pg8 {
constexpr int BM = 256, BK = 64, HALF = 128, HTB = HALF * BK * 2, STAGE_BYTES = 8 * HTB;
__host__ __device__ __forceinline__ int lds_byte(int r, int c) { const int st = (r >> 4) * 2 + (c >> 5), rr = r & 15, cc = c & 31, ob = rr * 64 + cc * 2; return st * 1024 + (ob ^ (((ob >> 9) & 1) << 5)); }
__host__ __device__ __forceinline__ void stage_rc(int b, int& R, int& C) { const int st = b / 1024, sb = b % 1024, swz = sb ^ (((sb >> 9) & 1) << 5); R = (st >> 1) * 16 + swz / 64; C = (st & 1) * 32 + (swz % 64) / 2; }
__host__ __device__ __forceinline__ int perm32(int rho) { const int n = rho >> 4, i = rho & 15; return 8 * (i >> 2) + 4 * n + (i & 3); }

struct Unit { int pm, pn; unsigned aoff, boff; int aux; };
struct Gemm { const bf16* A; const bf16* Bt; int K, lda, ldb; const int* rowidx; };

__device__ __forceinline__ unsigned cvt_pk_bf16(float lo, float hi) { unsigned r; asm volatile("v_cvt_pk_bf16_f32 %0, %1, %2" : "=v"(r) : "v"(lo), "v"(hi)); return r; }

#ifndef PG8_ALIGN_EPI
#define PG8_ALIGN_EPI 1
#endif
template <class Epi, class Sched, bool GATHER = false>
__device__ __forceinline__ void gemm_phase(LAS unsigned char* lds, const Gemm g, const Sched& S, const Epi& E) {
    const int tid = threadIdx.x, wid = __builtin_amdgcn_readfirstlane(tid >> 6), lane = tid & 63, wr = wid >> 2, wc = wid & 3, fr = lane & 15, fq = lane >> 4;
    int nt = g.K / BK; asm volatile("" : "+s"(nt));
    unsigned voffA[2], voffB[2];
#pragma unroll
    for (int i = 0; i < 2; ++i) { int R, C; stage_rc(tid * 16 + i * 8192, R, C); const int Rb = (R & ~31) + perm32(R & 31);
        voffA[i] = (unsigned)(R * g.lda + C) * 2u; voffB[i] = (unsigned)(Rb * g.ldb + C) * 2u; }
    const size_t kstep = (size_t)(BK * 2);
    unsigned gaC[2][2], gaN[2][2];
#define PG8_ROWS(ga, U) do { _Pragma("unroll") for (int _h = 0; _h < 2; ++_h) _Pragma("unroll") for (int _i = 0; _i < 2; ++_i) { int R, C; stage_rc(tid * 16 + _i * 8192, R, C); \
        ga[_h][_i] = (unsigned)g.rowidx[(U).pm * 256 + _h * 128 + R] * (unsigned)(g.lda * 2) + (unsigned)C * 2u; } } while (0)
#define PG8_STA(bufoff, nx, kb, h) do { if constexpr (GATHER) { unsigned _v[2]; _v[0] = (nx) ? gaN[h][0] : gaC[h][0]; _v[1] = (nx) ? gaN[h][1] : gaC[h][1]; PG8_STAGE(bufoff, (const char*)g.A + (kb), _v); } \
        else { PG8_STAGE(bufoff, ((nx) ? nA : cA) + (kb) + (h) * hstepA, voffA); } } while (0)
    const size_t hstepA = (size_t)HALF * g.lda * 2, hstepB = (size_t)HALF * g.ldb * 2;
    const size_t tstepA = 2 * hstepA, tstepB = 2 * hstepB;
    const unsigned ldsw = (unsigned)wid * 1024u;
    const int aoff = lds_byte(wr * 64 + fr, fq * 8), boff = lds_byte(wc * 32 + fr, fq * 8);
#define PG8_SA(b, h) (((b) * 2 + (h)) * HTB)
#define PG8_SB(b, h) ((4 + (b) * 2 + (h)) * HTB)
#define PG8_STAGE(bufoff, gbase, voff) do { _Pragma("unroll") for (int _i = 0; _i < 2; ++_i) \
        __builtin_amdgcn_global_load_lds((const unsigned*)((const char*)(gbase) + (voff)[_i]), (LAS unsigned*)(lds + (bufoff) + ldsw + _i * 8192), 16, 0, 0); } while (0)
#define PG8_LDA(dst, b, h) do { _Pragma("unroll") for (int m = 0; m < 4; ++m) _Pragma("unroll") for (int k = 0; k < 2; ++k) dst[m][k] = *(const LAS bf16x8*)(lds + PG8_SA(b, h) + aoff + m * 2048 + k * 1024); } while (0)
#define PG8_LDB(dst, b, h) do { _Pragma("unroll") for (int n = 0; n < 2; ++n) _Pragma("unroll") for (int k = 0; k < 2; ++k) dst[n][k] = *(const LAS bf16x8*)(lds + PG8_SB(b, h) + boff + n * 2048 + k * 1024); } while (0)
#define PG8_MMA(ai, bj, At, Bt) do { __builtin_amdgcn_s_setprio(1); _Pragma("unroll") for (int m = 0; m < 4; ++m) _Pragma("unroll") for (int n = 0; n < 2; ++n) _Pragma("unroll") for (int k = 0; k < 2; ++k) \
        acc[ai][bj][m][n] = __builtin_amdgcn_mfma_f32_16x16x32_bf16(Bt[n][k], At[m][k], acc[ai][bj][m][n], 0, 0, 0); __builtin_amdgcn_s_setprio(0); } while (0)
#define PG8_WAIT_V(n) asm volatile("s_waitcnt vmcnt(" #n ")" ::: "memory")
#define PG8_WAIT_L(n) asm volatile("s_waitcnt lgkmcnt(" #n ")" ::: "memory")
#define PG8_BAR __builtin_amdgcn_s_barrier()
#define PG8_SCHED __builtin_amdgcn_sched_barrier(0)
    Unit cur, nxt; int ui = 0;
    if (!S.next(0, cur)) return;
    f32x4 acc[2][2][4][2];
#pragma unroll
    for (int a = 0; a < 2; ++a)
#pragma unroll
        for (int b = 0; b < 2; ++b)
#pragma unroll
            for (int m = 0; m < 4; ++m)
#pragma unroll
                for (int n = 0; n < 2; ++n) acc[a][b][m][n] = (f32x4){0.f, 0.f, 0.f, 0.f};
    bf16x8 At[4][2], B0[2][2], B1[2][2];
    const char* cA = (const char*)g.A + (size_t)cur.pm * tstepA + cur.aoff; const char* cB = (const char*)g.Bt + (size_t)cur.pn * tstepB + cur.boff;
    const char* nA = cA;
    if constexpr (GATHER) PG8_ROWS(gaC, cur);
    PG8_STAGE(PG8_SB(0, 0), cB, voffB); PG8_STAGE(PG8_SB(0, 1), cB + hstepB, voffB); PG8_STA(PG8_SA(0, 0), false, 0, 0); PG8_STA(PG8_SA(0, 1), false, 0, 1);
    if (wr == 1) PG8_BAR;
    PG8_WAIT_V(2); PG8_BAR;
    PG8_STAGE(PG8_SB(1, 0), cB + kstep, voffB); PG8_STA(PG8_SA(1, 0), false, kstep, 0); PG8_STAGE(PG8_SB(1, 1), cB + hstepB + kstep, voffB);
    PG8_WAIT_V(6); PG8_BAR;
    for (;;) {
        const bool has_next = S.next(ui + 1, nxt);
        nA = has_next ? (const char*)g.A + (size_t)nxt.pm * tstepA + nxt.aoff : cA;
        if constexpr (GATHER) { if (has_next) PG8_ROWS(gaN, nxt); else { _Pragma("unroll") for (int _h = 0; _h < 2; ++_h) { gaN[_h][0] = gaC[_h][0]; gaN[_h][1] = gaC[_h][1]; } } }
        const char* nB = has_next ? (const char*)g.Bt + (size_t)nxt.pn * tstepB + nxt.boff : cB;
        for (int t = 0; t < nt; t += 2) {
            const bool last = (t == nt - 2);
            const size_t k1 = (size_t)(t + 1) * kstep, k2 = last ? 0 : (size_t)(t + 2) * kstep, k3 = k2 + kstep;
            const char* b2 = last ? nB : cB + (size_t)(t + 2) * kstep; const char* b3 = b2 + kstep;
            PG8_LDB(B0, 0, 0); PG8_LDB(B1, 0, 1); PG8_SCHED; PG8_LDA(At, 0, 0); PG8_STA(PG8_SA(1, 1), false, k1, 1);
            PG8_WAIT_V(8); PG8_WAIT_L(0); PG8_BAR; PG8_MMA(0, 0, At, B0); PG8_MMA(0, 1, At, B1); PG8_BAR; PG8_SCHED;
            PG8_LDA(At, 0, 1); PG8_STAGE(PG8_SB(0, 0), b2, voffB); PG8_STAGE(PG8_SB(0, 1), b2 + hstepB, voffB); PG8_STA(PG8_SA(0, 0), last, k2, 0);
            PG8_WAIT_V(8); PG8_WAIT_L(0); PG8_BAR; PG8_MMA(1, 0, At, B0); PG8_MMA(1, 1, At, B1); PG8_BAR; PG8_SCHED;
            PG8_LDB(B0, 1, 0); PG8_LDB(B1, 1, 1); PG8_SCHED; PG8_LDA(At, 1, 0); PG8_STA(PG8_SA(0, 1), last, k2, 1);
            PG8_WAIT_V(8); PG8_WAIT_L(0); PG8_BAR; PG8_MMA(0, 0, At, B0); PG8_MMA(0, 1, At, B1); PG8_BAR; PG8_SCHED;
            PG8_LDA(At, 1, 1); PG8_STAGE(PG8_SB(1, 0), b3, voffB); PG8_STAGE(PG8_SB(1, 1), b3 + hstepB, voffB); PG8_STA(PG8_SA(1, 0), last, k3, 0);
            PG8_WAIT_V(8); PG8_WAIT_L(0); PG8_BAR; PG8_MMA(1, 0, At, B0); PG8_MMA(1, 1, At, B1); PG8_BAR; PG8_SCHED;
        }
        if (PG8_ALIGN_EPI && wr == 0) PG8_BAR;
        E(acc, cur, wr, wc, fr, fq);
        if (!has_next) break;
#pragma unroll
        for (int a = 0; a < 2; ++a)
#pragma unroll
            for (int b = 0; b < 2; ++b)
#pragma unroll
                for (int m = 0; m < 4; ++m)
#pragma unroll
                    for (int n = 0; n < 2; ++n) acc[a][b][m][n] = (f32x4){0.f, 0.f, 0.f, 0.f};
        cur = nxt; cA = nA; cB = nB; ++ui;
        if constexpr (GATHER) { _Pragma("unroll") for (int _h = 0; _h < 2; ++_h) { gaC[_h][0] = gaN[_h][0]; gaC[_h][1] = gaN[_h][1]; } }
        if (PG8_ALIGN_EPI && wr == 1) PG8_BAR;
    }
    PG8_WAIT_V(0);
    if (!PG8_ALIGN_EPI && wr == 0) PG8_BAR;
    PG8_BAR;
#undef PG8_SA
#undef PG8_ROWS
#undef PG8_STA
#undef PG8_SB
#undef PG8_STAGE
#undef PG8_LDA
#undef PG8_LDB
#undef PG8_MMA
#undef PG8_WAIT_V
#undef PG8_WAIT_L
#undef PG8_BAR
#undef PG8_SCHED
}
}

#define XB_TMO      128
#define XB_XCNT(j)  (256  + 64 * (j))
#define XB_XSUB(j)  (1280 + 64 * (j))
#define XB_XGEN(j)  (2304 + 64 * (j))
#define XB_TOP      3328
#define XB_TOPGEN   3392
#define XCD_BAR_WORDS 3456
#define XB_SPIN_CAP (1u << 22)

__device__ __forceinline__ unsigned xb_ld(unsigned* p)              { return __hip_atomic_load(p, __ATOMIC_RELAXED, __HIP_MEMORY_SCOPE_AGENT); }
__device__ __forceinline__ unsigned xb_add(unsigned* p, unsigned v) { return __hip_atomic_fetch_add(p, v, __ATOMIC_RELAXED, __HIP_MEMORY_SCOPE_AGENT); }
__device__ __forceinline__ unsigned xb_xcc_id() { return (unsigned)__builtin_amdgcn_s_getreg((3 << 11) | 20) & 0xFu; }
#define XB_SPIN(cond, bar) do { unsigned _sp = 0; while (cond) { __builtin_amdgcn_s_sleep(1); \
    if ((++_sp & 255u) == 0u) { if (xb_ld(&(bar)[XB_TMO])) break; if (_sp > XB_SPIN_CAP) { atomicAdd(&(bar)[XB_TMO], 1u); break; } } } } while (0)

struct XcdBarrier { unsigned* bar; unsigned x; volatile LAS unsigned* st; };

__device__ __forceinline__ XcdBarrier xcd_barrier_post(unsigned* bar, volatile LAS unsigned* st) {
    XcdBarrier b; b.bar = bar; b.x = xb_xcc_id(); b.st = st;
    if (threadIdx.x == 0) (void)xb_add(&bar[XB_XCNT(b.x)], 1u);
    return b;
}
__device__ __forceinline__ void xcd_barrier_complete(unsigned* bar, unsigned x, unsigned& nloc, unsigned& nx) {
    const unsigned G = gridDim.x * gridDim.y * gridDim.z;
    unsigned sum, cnt, mine, sp = 0u;
    for (;;) {
        sum = 0u; cnt = 0u; mine = 0u;
#pragma unroll
        for (unsigned j = 0; j < 16; ++j) { const unsigned c = xb_ld(&bar[XB_XCNT(j)]); sum += c; cnt += (c > 0u) ? 1u : 0u; mine = (j == x) ? c : mine; }
        if (sum == G) break;
        __builtin_amdgcn_s_sleep(1);
        if ((++sp & 255u) == 0u) { if (xb_ld(&bar[XB_TMO])) break; if (sp > XB_SPIN_CAP) { atomicAdd(&bar[XB_TMO], 1u); break; } }
    }
    nloc = mine > 0u ? mine : 1u; nx = cnt > 0u ? cnt : 1u;
}
__device__ __forceinline__ void xcd_barrier(const XcdBarrier& b) {
    asm volatile("s_waitcnt vmcnt(0)" ::: "memory");
    __syncthreads();
    if (threadIdx.x == 0) {
        unsigned* bar = b.bar;
        __builtin_amdgcn_s_waitcnt(0);
        unsigned nloc = b.st[0], nx = b.st[1];
        if (nloc == 0u) { xcd_barrier_complete(bar, b.x, nloc, nx); b.st[0] = nloc; b.st[1] = nx; }
        const unsigned old = xb_add(&bar[XB_XSUB(b.x)], 1u);
        const unsigned gen = old / nloc;
        if (old + 1u == (gen + 1u) * nloc) {
            __builtin_amdgcn_fence(__ATOMIC_RELEASE, "agent");
            asm volatile("s_waitcnt vmcnt(0)" ::: "memory");
            const unsigned og = xb_add(&bar[XB_TOP], 1u);
            const unsigned tg = og / nx;
            if (og + 1u == (tg + 1u) * nx) xb_add(&bar[XB_TOPGEN], 1u);
            else XB_SPIN(xb_ld(&bar[XB_TOPGEN]) == tg, bar);
            __builtin_amdgcn_fence(__ATOMIC_ACQUIRE, "agent");
            xb_add(&bar[XB_XGEN(b.x)], 1u);
            asm volatile("s_waitcnt vmcnt(0)" ::: "memory");
        } else {
            XB_SPIN(xb_ld(&bar[XB_XGEN(b.x)]) == gen, bar);
            __builtin_amdgcn_fence(__ATOMIC_ACQUIRE, "agent");
            asm volatile("s_waitcnt vmcnt(0)" ::: "memory");
        }
    }
    __syncthreads();
}

__device__ __forceinline__ int proj_srccol(int n) {
    if (n < 1024) { const int base = (n < 512) ? OFF_Q : OFF_AK; const int m = n & 511, h = m >> 6, p = m & 63; return base + h * 64 + (p >> 1) + 32 * (p & 1); }
    if (n < 1536) return OFF_AV + (n - 1024);
    if (n < 2560) return OFF_GA + (n - 1536);
    if (n < 3584) return OFF_GR + (n - 2560);
    if (n < 3584 + RWC) return n - 3584;
    return -1;
}
template <bool MAP>
__device__ __forceinline__ void transpose_item(const float* W, int N, bf16* WT, int ldk, int k0, int n0, int kdst0, LAS float* scr, int lane) {
    const int nl = lane & 31;
    int col = n0 + nl; if (MAP) col = proj_srccol(col);
    float tv[32];
#pragma unroll
    for (int i = 0; i < 32; ++i) { const int kk = 2 * i + (lane >> 5); tv[i] = (col >= 0) ? __builtin_nontemporal_load(W + (size_t)(k0 + kk) * N + col) : 0.f; }
#pragma unroll
    for (int i = 0; i < 32; ++i) { const int kk = 2 * i + (lane >> 5); scr[kk * 33 + nl] = tv[i]; }
    LDS_WAIT(); asm volatile("" ::: "memory");
    const int c = lane & 7;
#pragma unroll
    for (int j = 0; j < 4; ++j) { const int n = (lane >> 3) + 8 * j; const LAS float* s = scr + (8 * c) * 33 + n;
        v4u o; o.x = pk2(s[0 * 33], s[1 * 33]); o.y = pk2(s[2 * 33], s[3 * 33]); o.z = pk2(s[4 * 33], s[5 * 33]); o.w = pk2(s[6 * 33], s[7 * 33]);
        *(GAS v4u*)(WT + (size_t)(n0 + n) * ldk + kdst0 + k0 + 8 * c) = o; }
    LDS_WAIT(); asm volatile("" ::: "memory");
}

struct GridOrder {
    int nM, nN, nwg, G, c, rsh; unsigned asec;
    __device__ __forceinline__ void init(int nM_, int nN_, int G_, int c_, unsigned asec_, int rsh_) { nM = nM_; nN = nN_; nwg = nM * nN; G = G_; c = c_; asec = asec_; rsh = rsh_; }
    __device__ __forceinline__ bool next(int i, pg8::Unit& u) const {
        const long L = (long)(i >> rsh) * G + c; if (L >= nwg) return false;
        int wgid = (int)L; { const int q = nwg / 8, r = nwg % 8, xcd = wgid % 8, off = wgid / 8; wgid = (xcd < r ? xcd * (q + 1) : r * (q + 1) + (xcd - r) * q) + off; }
#ifndef GO_WGM
#define GO_WGM 4
#endif
        const int nig = GO_WGM * nN, gid = wgid / nig, fm = gid * GO_WGM, gsz = (nM - fm) < GO_WGM ? (nM - fm) : GO_WGM;
        u.pm = fm + ((wgid % nig) % gsz); u.pn = (wgid % nig) / gsz; u.aoff = asec * (unsigned)(u.pn >> 1); u.boff = 0u; u.aux = 0; return true;
    }
};
struct MixOrder {
    int G, c, rsh;
    __device__ __forceinline__ bool next(int i, pg8::Unit& u) const {
        int tl; if (G == 256) tl = (c & 7) * 64 + (i >> (1 + rsh)) * 32 + (c >> 3); else tl = (i >> (1 + rsh)) * G + c;
        if (tl >= 512 || (G == 256 && (i >> (1 + rsh)) >= 2)) return false;
        u.pm = tl >> 2; u.pn = tl & 3; u.aux = i & 1; u.aoff = u.boff = (unsigned)(i & 1) * 1024u; return true;
    }
};
struct MoeOrder {
    int G, c, nN, ntiles; const int* tile_e; unsigned estride; int rsh;
    __device__ __forceinline__ bool next(int i, pg8::Unit& u) const {
        const int U = ntiles * nN; int L;
        if ((G & 7) == 0) { const int perX = (U + 7) >> 3, cpx = G >> 3, li = (i >> rsh) * cpx + (c >> 3); if (li >= perX) return false; L = (c & 7) * perX + li; if (L >= U) return false; }
        else { L = (i >> rsh) * G + c; if (L >= U) return false; }
#ifndef MOE_WGM
#define MOE_WGM 4
#endif
        { const int gsz0 = MOE_WGM * nN, gi = L / gsz0, fm = gi * MOE_WGM, rem = ntiles - fm, gr = rem < MOE_WGM ? rem : MOE_WGM, uu = L - gi * gsz0; u.pm = fm + uu % gr; u.pn = uu / gr; }
        const int e = __builtin_nontemporal_load(tile_e + u.pm); u.aux = e; u.aoff = 0u; u.boff = (unsigned)e * estride; return true;
    }
};

#define EPI_ARGS const f32x4 (&acc)[2][2][4][2], const pg8::Unit& u, int wr, int wc, int fr, int fq
__device__ __forceinline__ v4u pack8(const f32x4 a, const f32x4 b) { v4u w; w.x = pg8::cvt_pk_bf16(a[0], a[1]); w.y = pg8::cvt_pk_bf16(a[2], a[3]); w.z = pg8::cvt_pk_bf16(b[0], b[1]); w.w = pg8::cvt_pk_bf16(b[2], b[3]); return w; }

struct EpiProj {
    bf16 *QR, *KR, *VR, *SGA, *SGR; float *KMEAN; const float* ROPE;
    float *PRE, *PREV, *RAW0, *RAW63; bf16* APR; const float* mu_shift;
    __device__ __forceinline__ void operator()(EPI_ARGS) const {
        const int pn = u.pn, row0 = u.pm * 256 + wr * 64 + fr, bb = u.pm >> 6;
        if (pn < 4) {
            const bool isk = pn >= 2;
            float ks[2][8];
#pragma unroll
            for (int bj = 0; bj < 2; ++bj)
#pragma unroll
                for (int e = 0; e < 8; ++e) ks[bj][e] = 0.f;
#pragma unroll
            for (int ai2 = 0; ai2 < 4; ++ai2) { const int ai = ai2 >> 1, mb = (ai2 & 1) * 2;
                f32x4 cq[4][2], sq[4][2];
#pragma unroll
                for (int m = mb; m < mb + 2; ++m)
#pragma unroll
                    for (int bj = 0; bj < 2; ++bj) { const int s_ = (row0 + ai * 128 + m * 16) & (SEQ - 1), i0 = ((bj * 128 + wc * 32 + 8 * fq) & 63) >> 1;
                        cq[m][bj] = *(const f32x4*)(ROPE + (size_t)s_ * 32 + i0); sq[m][bj] = *(const f32x4*)(ROPE + (size_t)SEQ * 32 + (size_t)s_ * 32 + i0); }
#pragma unroll
                for (int m = mb; m < mb + 2; ++m) {
                    const int t = row0 + ai * 128 + m * 16, s_ = t & (SEQ - 1);
#pragma unroll
                    for (int bj = 0; bj < 2; ++bj) {
                        const int cs = (pn & 1) * 256 + bj * 128 + wc * 32 + 8 * fq, h = cs >> 6, p0 = cs & 63;
                        const f32x4 c4 = cq[m][bj], s4 = sq[m][bj];
                        const f32x4 v0 = acc[ai][bj][m][0], v1 = acc[ai][bj][m][1];
                        f32x4 o0, o1;
                        o0[0] = v0[0] * c4[0] - v0[1] * s4[0]; o0[1] = v0[1] * c4[0] + v0[0] * s4[0];
                        o0[2] = v0[2] * c4[1] - v0[3] * s4[1]; o0[3] = v0[3] * c4[1] + v0[2] * s4[1];
                        o1[0] = v1[0] * c4[2] - v1[1] * s4[2]; o1[1] = v1[1] * c4[2] + v1[0] * s4[2];
                        o1[2] = v1[2] * c4[3] - v1[3] * s4[3]; o1[3] = v1[3] * c4[3] + v1[2] * s4[3];
                        bf16* dst = (isk ? KR : QR) + (((size_t)(bb * 8 + h) * SEQ + s_) * 64 + p0);
                        if (isk) {
#pragma unroll
                            for (int e = 0; e < 4; ++e) { ks[bj][e] += o0[e]; ks[bj][4 + e] += o1[e]; }
                        } else { o0 = o0 * 0.125f; o1 = o1 * 0.125f; }
                        *(v4u*)dst = pack8(o0, o1);
                    }
                }
                asm volatile("" ::: "memory");
            }
            if (isk) {
#pragma unroll
                for (int bj = 0; bj < 2; ++bj)
#pragma unroll
                    for (int e = 0; e < 8; ++e) { float v = ks[bj][e]; v += __shfl_xor(v, 1); v += __shfl_xor(v, 2); v += __shfl_xor(v, 4); v += __shfl_xor(v, 8); ks[bj][e] = v; }
                if (fr == 0) {
#pragma unroll
                    for (int bj = 0; bj < 2; ++bj) {
                        const int cs = (pn & 1) * 256 + bj * 128 + wc * 32 + 8 * fq, h = cs >> 6, p0 = cs & 63;
                        float* km = KMEAN + ((size_t)((bb * 8 + h) * NBLK + (u.pm & 63)) * 64 + p0);
#pragma unroll
                        for (int e = 0; e < 8; ++e) atomicAdd(km + e, ks[bj][e]);
                    }
                }
            }
        } else if (pn < 6) {
#pragma unroll
            for (int ai = 0; ai < 2; ++ai)
#pragma unroll
                for (int m = 0; m < 4; ++m) {
                    const int t = row0 + ai * 128 + m * 16, s = t & (SEQ - 1);
#pragma unroll
                    for (int bj = 0; bj < 2; ++bj) {
                        const int cs = (pn & 1) * 256 + bj * 128 + wc * 32 + 8 * fq, h = cs >> 6, p0 = cs & 63;
                        *(v4u*)(VR + (((size_t)(bb * 8 + h) * SEQ + s) * 64 + p0)) = pack8(acc[ai][bj][m][0], acc[ai][bj][m][1]);
                    }
                }
        } else if (pn < 14) {
            bf16* G = (pn < 10) ? SGA : SGR; const int cb = ((pn - 6) & 3) * 256;
#pragma unroll
            for (int ai = 0; ai < 2; ++ai)
#pragma unroll
                for (int m = 0; m < 4; ++m) {
                    const int t = row0 + ai * 128 + m * 16;
#pragma unroll
                    for (int bj = 0; bj < 2; ++bj) {
                        const int cs = cb + bj * 128 + wc * 32 + 8 * fq;
                        f32x4 a = acc[ai][bj][m][0], b = acc[ai][bj][m][1];
#pragma unroll
                        for (int e = 0; e < 4; ++e) { a[e] = sigmoidf_(a[e]); b[e] = sigmoidf_(b[e]); }
                        *(v4u*)(G + (size_t)t * 1024 + cs) = pack8(a, b);
                    }
                }
        } else {
            const int seg = (pn - 14) >> 1;
            f32x4 mq[2][2];
#pragma unroll
            for (int bj = 0; bj < 2; ++bj) { const int r = (pn - 14) * 256 + bj * 128 + wc * 32 + 8 * fq;
                if (r < RWC) { mq[bj][0] = *(const f32x4*)(mu_shift + r); mq[bj][1] = *(const f32x4*)(mu_shift + r + 4); } else { mq[bj][0] = (f32x4){0.f, 0.f, 0.f, 0.f}; mq[bj][1] = mq[bj][0]; } }
#pragma unroll
            for (int ai = 0; ai < 2; ++ai)
#pragma unroll
                for (int m = 0; m < 4; ++m) {
                    const int t = row0 + ai * 128 + m * 16;
#pragma unroll
                    for (int bj = 0; bj < 2; ++bj) {
                        const int r = (pn - 14) * 256 + bj * 128 + wc * 32 + 8 * fq, rl = r & 511;
                        f32x4 c0 = acc[ai][bj][m][0], c1 = acc[ai][bj][m][1], p0, p1;
#pragma unroll
                        for (int e = 0; e < 4; ++e) {
                            float up0 = 0.f, up1 = 0.f; const float x0 = c0[e], x1 = c1[e];
                            asm volatile("s_nop 1\n\tv_mov_b32_dpp %0, %1 row_shr:1 row_mask:0xf bank_mask:0xf" : "+v"(up0) : "v"(x0));
                            asm volatile("s_nop 1\n\tv_mov_b32_dpp %0, %1 row_shr:1 row_mask:0xf bank_mask:0xf" : "+v"(up1) : "v"(x1));
                            if (m > 0) {
                                float cy0 = 0.f, cy1 = 0.f; const float y0 = acc[ai][bj][m > 0 ? m - 1 : 0][0][e], y1 = acc[ai][bj][m > 0 ? m - 1 : 0][1][e];
                                asm volatile("s_nop 1\n\tv_mov_b32_dpp %0, %1 row_newbcast:15 row_mask:0xf bank_mask:0xf" : "+v"(cy0) : "v"(y0));
                                asm volatile("s_nop 1\n\tv_mov_b32_dpp %0, %1 row_newbcast:15 row_mask:0xf bank_mask:0xf" : "+v"(cy1) : "v"(y1));
                                up0 = fr == 0 ? cy0 : up0; up1 = fr == 0 ? cy1 : up1;
                            }
                            p0[e] = up0; p1[e] = up1;
                        }
                        f32x4 s0 = c0 + (p0 - c0) * mq[bj][0], s1 = c1 + (p1 - c1) * mq[bj][1];
                        if (m == 0 && fr == 0) { s0 = c0; s1 = c1; float* d = RAW0 + (size_t)(t >> 6) * 2048 + r; *(f32x4*)d = c0; *(f32x4*)(d + 4) = c1; }
                        if (m == 3 && fr == 15) { float* d = RAW63 + (size_t)(t >> 6) * 2048 + r; *(f32x4*)d = c0; *(f32x4*)(d + 4) = c1; }
                        if (seg == 0) { float* d = PRE + ((size_t)t * 8 + (rl >> 6)) * 320 + 256 + (rl & 63); *(f32x4*)d = s0; *(f32x4*)(d + 4) = s1; }
                        else if (seg == 1) { float* d = PRE + ((size_t)t * 8 + (rl >> 6)) * 320 + 192 + (rl & 63); *(f32x4*)d = s0; *(f32x4*)(d + 4) = s1; }
                        else if (seg == 2) { float* d = PREV + (size_t)t * 512 + rl; *(f32x4*)d = s0; *(f32x4*)(d + 4) = s1; }
                        else {
                            const int kind = rl < 64 ? 0 : (rl < 128 ? 1 : 2);
#pragma unroll
                            for (int e = 0; e < 4; ++e) {
                                if (kind == 0) { s0[e] = 2.0f * sigmoidf_(2.0f * s0[e]) - 1.0f; s1[e] = 2.0f * sigmoidf_(2.0f * s1[e]) - 1.0f; }
                                else if (kind == 2) { s0[e] = sigmoidf_(s0[e]); s1[e] = sigmoidf_(s1[e]); } }
                            *(v4u*)(APR + (size_t)t * 512 + rl) = pack8(s0, s1);
                        }
                    }
                    asm volatile("" ::: "memory");
                }
        }
    }
};

struct EpiLora {
    float *PRE, *G; const float *w0, *a0;
    __device__ __forceinline__ void operator()(EPI_ARGS) const {
        const int sec = u.pn >> 1, row0 = u.pm * 256 + wr * 64 + fr, cb = (u.pn & 1) * 256 + wc * 32 + 8 * fq;
        if (sec < 2) {
            const float* cst = sec ? a0 : w0; f32x4 wq[2][2];
#pragma unroll
            for (int bj = 0; bj < 2; ++bj) { wq[bj][0] = *(const f32x4*)(cst + cb + bj * 128); wq[bj][1] = *(const f32x4*)(cst + cb + bj * 128 + 4); }
#pragma unroll
            for (int ai = 0; ai < 2; ++ai) {
#pragma unroll
                for (int m = 0; m < 4; ++m)
#pragma unroll
                    for (int bj = 0; bj < 2; ++bj) {
                        const int t = row0 + ai * 128 + m * 16, c = cb + bj * 128;
                        float* pre = PRE + ((size_t)t * 8 + (c >> 6)) * 320 + (c & 63) + (sec ? 128 : 64);
                        f32x4 o0, o1;
#pragma unroll
                        for (int e = 0; e < 4; ++e) {
                            const float z0 = sigmoidf_(wq[bj][0][e] + acc[ai][bj][m][0][e]), z1 = sigmoidf_(wq[bj][1][e] + acc[ai][bj][m][1][e]);
                            o0[e] = sec ? z0 : __expf(-0.6065306597126334f * z0); o1[e] = sec ? z1 : __expf(-0.6065306597126334f * z1); }
                        *(f32x4*)pre = o0; *(f32x4*)(pre + 4) = o1;
                    }
                asm volatile("" ::: "memory");
            }
        } else {
#pragma unroll
            for (int ai = 0; ai < 2; ++ai)
#pragma unroll
                for (int m = 0; m < 4; ++m)
#pragma unroll
                    for (int bj = 0; bj < 2; ++bj) {
                        const int t = row0 + ai * 128 + m * 16, c = cb + bj * 128;
                        float* d = G + (size_t)t * 512 + c; *(f32x4*)d = acc[ai][bj][m][0]; *(f32x4*)(d + 4) = acc[ai][bj][m][1];
                    }
        }
    }
};

struct EpiMix {
    bf16 *MIXED; const bf16 *SGA, *SGR;
    __device__ __forceinline__ void operator()(EPI_ARGS) const {
        const int row0 = u.pm * 256 + wr * 64 + fr; const bf16* SG = u.aux ? SGR : SGA;
        const size_t cofs = (size_t)u.pn * 256 + wc * 32 + 8 * fq;
#pragma unroll
        for (int ai = 0; ai < 2; ++ai) {
            v4u gq[4][2], pq[4][2];
#pragma unroll
            for (int m = 0; m < 4; ++m)
#pragma unroll
                for (int bj = 0; bj < 2; ++bj) { const size_t off = (size_t)(row0 + ai * 128 + m * 16) * 1024 + cofs + bj * 128; gq[m][bj] = *(const v4u*)(SG + off); if (u.aux) pq[m][bj] = *(const v4u*)(MIXED + off); }
#pragma unroll
            for (int m = 0; m < 4; ++m)
#pragma unroll
                for (int bj = 0; bj < 2; ++bj) {
                    const size_t off = (size_t)(row0 + ai * 128 + m * 16) * 1024 + cofs + bj * 128; const v4u g = gq[m][bj];
                    f32x4 a = acc[ai][bj][m][0], b = acc[ai][bj][m][1];
                    a[0] *= bflo(g.x); a[1] *= bfhi(g.x); a[2] *= bflo(g.y); a[3] *= bfhi(g.y); b[0] *= bflo(g.z); b[1] *= bfhi(g.z); b[2] *= bflo(g.w); b[3] *= bfhi(g.w);
                    if (u.aux) { const v4u p = pq[m][bj];
                        a[0] += bflo(p.x); a[1] += bfhi(p.x); a[2] += bflo(p.y); a[3] += bfhi(p.y); b[0] += bflo(p.z); b[1] += bfhi(p.z); b[2] += bflo(p.w); b[3] += bfhi(p.w); }
                    *(v4u*)(MIXED + off) = pack8(a, b);
                }
            asm volatile("" ::: "memory");
        }
    }
};

struct EpiOut {
    float* PRE1; const float* X;
    __device__ __forceinline__ void operator()(EPI_ARGS) const {
        const int row0 = u.pm * 256 + wr * 64 + fr; const size_t cofs = (size_t)u.pn * 256 + wc * 32 + 8 * fq;
#pragma unroll
        for (int ai = 0; ai < 2; ++ai) {
            f32x4 x0[4][2], x1[4][2];
#pragma unroll
            for (int m = 0; m < 4; ++m)
#pragma unroll
                for (int bj = 0; bj < 2; ++bj) { const size_t off = (size_t)(row0 + ai * 128 + m * 16) * 1024 + cofs + bj * 128; x0[m][bj] = __builtin_nontemporal_load((const f32x4*)(X + off)); x1[m][bj] = __builtin_nontemporal_load((const f32x4*)(X + off + 4)); }
#pragma unroll
            for (int m = 0; m < 4; ++m)
#pragma unroll
                for (int bj = 0; bj < 2; ++bj) { const size_t off = (size_t)(row0 + ai * 128 + m * 16) * 1024 + cofs + bj * 128;
                    *(f32x4*)(PRE1 + off) = x0[m][bj] * ALPHA + acc[ai][bj][m][0]; *(f32x4*)(PRE1 + off + 4) = x1[m][bj] * ALPHA + acc[ai][bj][m][1]; }
            asm volatile("" ::: "memory");
        }
    }
};

struct EpiW1 {
    bf16* ACT; const float* b1;
    __device__ __forceinline__ void operator()(EPI_ARGS) const {
        const int row0 = u.pm * 256 + wr * 64 + fr; const float* be = b1 + (size_t)u.aux * 2048 + u.pn * 256 + wc * 32 + 8 * fq;
        f32x4 bv[2][2];
#pragma unroll
        for (int bj = 0; bj < 2; ++bj) { bv[bj][0] = *(const f32x4*)(be + bj * 128); bv[bj][1] = *(const f32x4*)(be + bj * 128 + 4); }
#pragma unroll
        for (int ai = 0; ai < 2; ++ai) {
#pragma unroll
            for (int m = 0; m < 4; ++m) {
                const int r = row0 + ai * 128 + m * 16;
#pragma unroll
                for (int bj = 0; bj < 2; ++bj) {
                    const int c = u.pn * 256 + bj * 128 + wc * 32 + 8 * fq;
                    const f32x4 h0 = acc[ai][bj][m][0] + bv[bj][0], h1 = acc[ai][bj][m][1] + bv[bj][1];
                    float o[4];
#pragma unroll
                    for (int e = 0; e < 4; ++e) { const float gl = fminf(e < 2 ? h0[2 * e] : h1[2 * e - 4], SW_LIMIT); float ln = e < 2 ? h0[2 * e + 1] : h1[2 * e - 3]; ln = fminf(fmaxf(ln, -SW_LIMIT), SW_LIMIT);
                        o[e] = gl * sigmoidf_(SW_ALPHA * gl) * (ln + 1.0f); }
                    v2u w; w.x = pg8::cvt_pk_bf16(o[0], o[1]); w.y = pg8::cvt_pk_bf16(o[2], o[3]);
                    *(v2u*)(ACT + (size_t)r * 1024 + (c >> 1)) = w;
                }
            }
            asm volatile("" ::: "memory");
        }
    }
};

struct EpiW2 {
    bf16* YS; const float* b2; const float* SLOTG;
    __device__ __forceinline__ void operator()(EPI_ARGS) const {
        const int row0 = u.pm * 256 + wr * 64 + fr; const float* be = b2 + (size_t)u.aux * 1024 + u.pn * 256 + wc * 32 + 8 * fq;
        f32x4 bv[2][2]; float gt[2][4];
#pragma unroll
        for (int bj = 0; bj < 2; ++bj) { bv[bj][0] = *(const f32x4*)(be + bj * 128); bv[bj][1] = *(const f32x4*)(be + bj * 128 + 4); }
#pragma unroll
        for (int ai = 0; ai < 2; ++ai)
#pragma unroll
            for (int m = 0; m < 4; ++m) gt[ai][m] = SLOTG[row0 + ai * 128 + m * 16];
#pragma unroll
        for (int ai = 0; ai < 2; ++ai) {
#pragma unroll
            for (int m = 0; m < 4; ++m) {
                const int r = row0 + ai * 128 + m * 16;
#pragma unroll
                for (int bj = 0; bj < 2; ++bj) {
                    const int c = u.pn * 256 + bj * 128 + wc * 32 + 8 * fq;
                    const f32x4 y0 = (acc[ai][bj][m][0] + bv[bj][0]) * gt[ai][m], y1 = (acc[ai][bj][m][1] + bv[bj][1]) * gt[ai][m];
                    *(v4u*)(YS + (size_t)r * 1024 + c) = pack8(y0, y1);
                }
            }
            asm volatile("" ::: "memory");
        }
    }
};

__device__ __forceinline__ void phase_p0(const float* x, const float* w_in, const float* w_abr, const float* w_rbr, const float* w_out,
                                         const float* w_du, const float* w_au, const float* w_gu, unsigned char* ws, LAS unsigned char* lds, int gw, int NGW, int wave, int lane) {
    LAS float* scr = (LAS float*)(lds + wave * 16384);
    bf16* WIN = (bf16*)(ws + WS_WIN); bf16* WBR = (bf16*)(ws + WS_WBR); bf16* WOUT = (bf16*)(ws + WS_WOUT); bf16* WLORA = (bf16*)(ws + WS_WLORA);
    constexpr int I_IN = 16 * (NPROJ / 32), I_BR = 8 * 32, I_OUT = 16 * 32;
    constexpr int NITEMS = I_IN + 2 * I_BR + I_OUT;
    for (int it = gw; it < NITEMS; it += NGW) {
        int r = it;
        if (r < I_IN) { const int nb = r % (NPROJ / 32), kb = r / (NPROJ / 32); transpose_item<true>(w_in, IN_COLS, WIN, 1024, 64 * kb, 32 * nb, 0, scr, lane); continue; } r -= I_IN;
        if (r < I_BR) { transpose_item<false>(w_abr, 1024, WBR, 1024, 64 * (r / 32), 32 * (r % 32), 0, scr, lane); continue; } r -= I_BR;
        if (r < I_BR) { transpose_item<false>(w_rbr, 1024, WBR, 1024, 64 * (r / 32), 32 * (r % 32), 512, scr, lane); continue; } r -= I_BR;
        transpose_item<false>(w_out, 1024, WOUT, 1024, 64 * (r / 32), 32 * (r % 32), 0, scr, lane);
    }
    const int gt = gw * 64 + lane, NGT = NGW * 64;
    for (int i = gt; i < 1536 * 256; i += NGT) { const int n = i >> 8, k = i & 255, sec = n >> 9, c = n & 511;
        float v = 0.f; if (sec == 0) { if (k < 64) v = w_du[k * 512 + c]; } else if (sec == 1) { if (k < 64) v = w_au[k * 512 + c]; } else { if (k < 160) v = w_gu[k * 512 + c]; }
        WLORA[i] = (bf16)f2bf(v); }
    float* ROPE = (float*)(ws + WS_ROPE);
    for (int i = gt; i < SEQ * 32; i += NGT) { const int s = i >> 5, f = i & 31; const double inv = pow(10000.0, -(double)f / 32.0), ang = (double)s * inv; double sn, cs; sincos(ang, &sn, &cs);
        ROPE[i] = (float)cs; ROPE[SEQ * 32 + i] = (float)sn; }
    bf16* XB = (bf16*)(ws + WS_XB);
    for (size_t i0 = gt; i0 < (size_t)T * 1024 / 8; i0 += (size_t)NGT * 4) {
        f32x4 a[4], b[4];
#pragma unroll
        for (int q = 0; q < 4; ++q) { const size_t i = i0 + (size_t)q * NGT; if (i < (size_t)T * 128) { a[q] = __builtin_nontemporal_load((const f32x4*)(x + i * 8)); b[q] = __builtin_nontemporal_load((const f32x4*)(x + i * 8 + 4)); } }
#pragma unroll
        for (int q = 0; q < 4; ++q) { const size_t i = i0 + (size_t)q * NGT; if (i < (size_t)T * 128) {
            v4u o; o.x = pk2(a[q][0], a[q][1]); o.y = pk2(a[q][2], a[q][3]); o.z = pk2(b[q][0], b[q][1]); o.w = pk2(b[q][2], b[q][3]); *(v4u*)(XB + i * 8) = o; } }
    }
}

__device__ __forceinline__ float tshift(float cur, float prev, float mu) { return cur + (prev - cur) * mu; }
__device__ __forceinline__ void phase_p2_fix(const float* mu_shift, unsigned char* ws, float* PREV, int gw, int NGW, int lane) {
    const float* RAW0 = (const float*)(ws + WS_RW); const float* RAW63 = RAW0 + (size_t)(T / 64) * 2048; float* PRE = (float*)(ws + WS_PRE); bf16* APR = (bf16*)(ws + WS_APR);
    const int gt = gw * 64 + lane, NGT = NGW * 64;
    for (int i0 = gt; i0 < (T / 64) * 2048; i0 += NGT * 8) {
        float cv[8], pv[8], mv[8];
#pragma unroll
        for (int q = 0; q < 8; ++q) { const int idx = i0 + q * NGT; const int ii = idx < (T / 64) * 2048 ? idx : i0; const int n = ii >> 11, c = ii & 2047;
            const bool hp = ((n * 64) & (SEQ - 1)) != 0;
            cv[q] = RAW0[ii]; pv[q] = RAW63[hp ? ii - 2048 : ii]; mv[q] = mu_shift[c < RWC ? c : 0]; }
#pragma unroll
        for (int q = 0; q < 8; ++q) { const int idx = i0 + q * NGT; if (idx < (T / 64) * 2048) {
            const int n = idx >> 11, c = idx & 2047, t = n * 64, rl = c & 511; const bool hp = (t & (SEQ - 1)) != 0;
            const float sh = tshift(cv[q], hp ? pv[q] : 0.f, c < RWC ? mv[q] : 0.f);
            if (c < 512) PRE[((size_t)t * 8 + (rl >> 6)) * 320 + 256 + (rl & 63)] = sh;
            else if (c < 1024) PRE[((size_t)t * 8 + (rl >> 6)) * 320 + 192 + (rl & 63)] = sh;
            else if (c < 1536) PREV[(size_t)t * 512 + rl] = sh;
            else { const float a = rl < 64 ? 2.0f * sigmoidf_(2.0f * sh) - 1.0f : (rl < 128 ? sh : sigmoidf_(sh)); APR[(size_t)t * 512 + rl] = (bf16)f2bf(a); } } }
    }
}
__device__ __forceinline__ void phase_p2_gate(unsigned char* ws, LAS unsigned char* lds, int gw, int NGW, int wave, int lane) {
    const bf16* QR = (const bf16*)(ws + WS_QR); const float* KMEAN = (const float*)(ws + WS_KMEAN); unsigned* SEL = (unsigned*)(ws + WS_SEL);
    LAS float* km = (LAS float*)(lds + wave * 16384);
    for (int it = gw; it < 4096; it += NGW) {
        const int q4 = it & 3, ib = (it >> 2) & 63, h = (it >> 8) & 7, b = it >> 11, i = b ? 63 - ib : ib;
        const float* kmg = KMEAN + (size_t)((b * 8 + h) * NBLK) * 64;
        for (int j0 = 0; j0 < i; j0 += 8) {
            float kv[8];
#pragma unroll
            for (int q = 0; q < 8; ++q) { const int jj = (j0 + q < i) ? j0 + q : i - 1; kv[q] = kmg[jj * 64 + lane]; }
#pragma unroll
            for (int q = 0; q < 8; ++q) if (j0 + q < i) km[(j0 + q) * 64 + lane] = kv[q] * (1.0f / 256.0f);
        }
        LDS_WAIT(); asm volatile("" ::: "memory");
        const int s = i * 256 + q4 * 64 + lane, t = b * SEQ + s;
        const bf16* qrow = QR + ((size_t)(b * 8 + h) * SEQ + s) * 64;
        float q[64];
#pragma unroll
        for (int c = 0; c < 8; ++c) { const v4u w = *(const v4u*)(qrow + c * 8);
            q[c * 8 + 0] = bflo(w.x); q[c * 8 + 1] = bfhi(w.x); q[c * 8 + 2] = bflo(w.y); q[c * 8 + 3] = bfhi(w.y); q[c * 8 + 4] = bflo(w.z); q[c * 8 + 5] = bfhi(w.z); q[c * 8 + 6] = bflo(w.w); q[c * 8 + 7] = bfhi(w.w); }
        float b0 = -__builtin_inff(), b1 = b0, b2 = b0; unsigned i0 = 255u, i1 = 255u, i2 = 255u;
        for (int j = 0; j < i; ++j) {
            const LAS f32x4* kj = (const LAS f32x4*)(km + j * 64);
            float d0 = 0.f, d1 = 0.f, d2 = 0.f, d3 = 0.f;
#pragma unroll
            for (int c = 0; c < 16; ++c) { const f32x4 kv = kj[c]; d0 += q[4 * c] * kv[0]; d1 += q[4 * c + 1] * kv[1]; d2 += q[4 * c + 2] * kv[2]; d3 += q[4 * c + 3] * kv[3]; }
            const float dot = (d0 + d1) + (d2 + d3);
            if (dot > b0) { b2 = b1; i2 = i1; b1 = b0; i1 = i0; b0 = dot; i0 = (unsigned)j; }
            else if (dot > b1) { b2 = b1; i2 = i1; b1 = dot; i1 = (unsigned)j; }
            else if (dot > b2) { b2 = dot; i2 = (unsigned)j; }
        }
        SEL[(size_t)t * 8 + h] = i0 | (i1 << 8) | (i2 << 16) | 0xFF000000u;
        LDS_WAIT(); asm volatile("" ::: "memory");
    }
}

template <int N, int MODE = 0> __device__ __forceinline__ void fmac_bc(float& acc, float src, float other) {
    if constexpr (MODE == 0) asm volatile("v_fmac_f32_dpp %0, %1, %2 row_newbcast:%3 row_mask:0xf bank_mask:0xf" : "+v"(acc) : "v"(src), "v"(other), "n"(N));
    else if constexpr (MODE == 1) asm volatile("v_fmac_f32_dpp %0, %1, %2 quad_perm:[%3,%3,%3,%3] row_mask:0xf bank_mask:0xf" : "+v"(acc) : "v"(src), "v"(other), "n"(N & 3));
    else asm volatile("v_fmac_f32_e32 %0, %1, %2" : "+v"(acc) : "v"(src), "v"(other));
}
template <int N, int MODE = 0> __device__ __forceinline__ void mul_bc(float& h, float src) {
    if constexpr (MODE == 0) asm volatile("v_mul_f32_dpp %0, %1, %0 row_newbcast:%2 row_mask:0xf bank_mask:0xf" : "+v"(h) : "v"(src), "n"(N));
    else if constexpr (MODE == 1) asm volatile("v_mul_f32_dpp %0, %1, %0 quad_perm:[%2,%2,%2,%2] row_mask:0xf bank_mask:0xf" : "+v"(h) : "v"(src), "n"(N & 3));
    else asm volatile("v_mul_f32_e32 %0, %1, %0" : "+v"(h) : "v"(src));
}

__device__ __forceinline__ void split8(const f32x4 a, const f32x4 b, bf16x8& hi, bf16x8& lo) {
    v4u h; h.x = pg8::cvt_pk_bf16(a[0], a[1]); h.y = pg8::cvt_pk_bf16(a[2], a[3]); h.z = pg8::cvt_pk_bf16(b[0], b[1]); h.w = pg8::cvt_pk_bf16(b[2], b[3]);
    v4u l; l.x = pg8::cvt_pk_bf16(a[0] - bflo(h.x), a[1] - bfhi(h.x)); l.y = pg8::cvt_pk_bf16(a[2] - bflo(h.y), a[3] - bfhi(h.y));
    l.z = pg8::cvt_pk_bf16(b[0] - bflo(h.z), b[1] - bfhi(h.z)); l.w = pg8::cvt_pk_bf16(b[2] - bflo(h.w), b[3] - bfhi(h.w));
    hi = __builtin_bit_cast(bf16x8, h); lo = __builtin_bit_cast(bf16x8, l);
}
__device__ __forceinline__ void phase_p4_chain(unsigned char* ws, LAS unsigned char* lds, int bh, int wave, int lane) {
    const float* MN = (const float*)(ws + WS_MN); float* HC = (float*)(ws + WS_HC);
    LAS float* Hs = (LAS float*)lds;
    const int rt = wave >> 1, c0 = 2 * (wave & 1), ql = lane & 15, g = lane >> 4;
    for (int i = threadIdx.x; i < 64 * 68; i += NTHR) Hs[i] = 0.f;
    const float* mbase = MN + ((size_t)(bh * NCH) * 2) * 4096;
    const float* mrow = mbase + (16 * rt + ql) * 64 + 8 * g;
    const float* nrow = mbase + 4096 + (16 * c0 + ql) * 64 + 16 * rt + 4 * g;
    {
        float* snap = HC + (size_t)(bh * NCH) * 4096;
        for (int i = threadIdx.x; i < 1024; i += NTHR) *(f32x4*)(snap + 4 * i) = (f32x4){0.f, 0.f, 0.f, 0.f};
    }
    __syncthreads();
    struct CSet { f32x4 m00, m01, m10, m11, n0, n1; };
#define CH_LOAD(S, c_) do { const size_t o = (size_t)(((c_) < NCH - 1) ? (c_) : (NCH - 2)) * 8192; \
        S.m00 = *(const f32x4*)(mrow + o); S.m01 = *(const f32x4*)(mrow + o + 4); S.m10 = *(const f32x4*)(mrow + o + 32); S.m11 = *(const f32x4*)(mrow + o + 36); \
        S.n0 = *(const f32x4*)(nrow + o); S.n1 = *(const f32x4*)(nrow + o + 1024); } while (0)
#define CH_STEP(S, c_) do { \
        bf16x8 ah[2], al[2]; split8(S.m00, S.m01, ah[0], al[0]); split8(S.m10, S.m11, ah[1], al[1]); \
        f32x4 acc[2] = {S.n0, S.n1}; \
        _Pragma("unroll") for (int ci = 0; ci < 2; ++ci) { const LAS float* hcol = Hs + (16 * (c0 + ci) + ql) * 68 + 8 * g; \
            _Pragma("unroll") for (int sI = 0; sI < 2; ++sI) { bf16x8 bh_, bl_; \
                split8(*(const LAS f32x4*)(hcol + 32 * sI), *(const LAS f32x4*)(hcol + 32 * sI + 4), bh_, bl_); \
                acc[ci] = __builtin_amdgcn_mfma_f32_16x16x32_bf16(ah[sI], bh_, acc[ci], 0, 0, 0); \
                acc[ci] = __builtin_amdgcn_mfma_f32_16x16x32_bf16(al[sI], bh_, acc[ci], 0, 0, 0); \
                acc[ci] = __builtin_amdgcn_mfma_f32_16x16x32_bf16(ah[sI], bl_, acc[ci], 0, 0, 0); } } \
        __syncthreads(); \
        float* snap = HC + (size_t)(bh * NCH + (c_) + 1) * 4096; \
        _Pragma("unroll") for (int ci = 0; ci < 2; ++ci) { const int col = 16 * (c0 + ci) + ql; \
            *(LAS f32x4*)(Hs + col * 68 + 16 * rt + 4 * g) = acc[ci]; *(f32x4*)(snap + col * 64 + 16 * rt + 4 * g) = acc[ci]; } \
        __syncthreads(); } while (0)
    CSet s0, s1, s2, s3, s4, s5;
    CH_LOAD(s0, 0); CH_LOAD(s1, 1); CH_LOAD(s2, 2); CH_LOAD(s3, 3); CH_LOAD(s4, 4);
    for (int c = 0; c < NCH - 1; c += 6) {
        CH_LOAD(s5, c + 5); CH_STEP(s0, c);
        if (c + 1 < NCH - 1) { CH_LOAD(s0, c + 6); CH_STEP(s1, c + 1); }
        if (c + 2 < NCH - 1) { CH_LOAD(s1, c + 7); CH_STEP(s2, c + 2); }
        if (c + 3 < NCH - 1) { CH_LOAD(s2, c + 8); CH_STEP(s3, c + 3); }
        if (c + 4 < NCH - 1) { CH_LOAD(s3, c + 9); CH_STEP(s4, c + 4); }
        if (c + 5 < NCH - 1) { CH_LOAD(s4, c + 10); CH_STEP(s5, c + 5); }
    }
#undef CH_LOAD
#undef CH_STEP
}

__device__ __forceinline__ void attn_unit(unsigned char* ws, LAS unsigned char* lds, int bh, int j, bool own, int tid, int wave, int lane) {
    const bf16* QR = (const bf16*)(ws + WS_QR); const bf16* KR = (const bf16*)(ws + WS_KR); const bf16* VR = (const bf16*)(ws + WS_VR);
    const unsigned* SEL = (const unsigned*)(ws + WS_SEL);
    bf16* PO = (bf16*)(ws + WS_PO); float* PM = (float*)(ws + WS_PM); float* PL = (float*)(ws + WS_PL);
    LAS unsigned char* KS = lds; LAS unsigned char* VS = lds + 32768;
    LAS unsigned short* LIST = (LAS unsigned short*)(lds + 65536); LAS unsigned* CNT = (LAS unsigned*)(lds + 65536 + 32768);
    const int b = bh >> 3, h = bh & 7;
    __syncthreads();
    if (tid == 0) *CNT = 0u;
    {
        const bf16* Kg = KR + ((size_t)bh * SEQ + j * 256) * 64; const bf16* Vg = VR + ((size_t)bh * SEQ + j * 256) * 64;
#pragma unroll
        for (int i = 0; i < 4; ++i) {
            const int q = tid + 512 * i, key = q >> 3, c = q & 7;
            const v4u kv = *(const v4u*)(Kg + key * 64 + c * 8);
            *(LAS v4u*)(KS + key * 128 + ((c ^ ((key >> 1) & 7)) << 4)) = kv;
            const v4u vv = *(const v4u*)(Vg + key * 64 + c * 8);
            const int pos = (key & ~31) + 8 * ((key >> 2) & 3) + 4 * ((key >> 4) & 1) + (key & 3), cc = pos >> 3, pw = (pos & 7) * 2;
            const unsigned wv[4] = {vv.x, vv.y, vv.z, vv.w};
#pragma unroll
            for (int e = 0; e < 8; ++e) { const int d = c * 8 + e; const unsigned short val = (unsigned short)((e & 1) ? (wv[e >> 1] >> 16) : (wv[e >> 1] & 0xffffu));
                *(LAS unsigned short*)(VS + d * 512 + ((cc ^ (d & 15)) << 4) + pw) = val; }
        }
    }
    __syncthreads();
    int cnt = 256;
    if (!own) {
        for (int tt = (j + 1) * 256; tt < SEQ; tt += 2048) {
            unsigned wq[4];
#pragma unroll
            for (int q = 0; q < 4; ++q) { const int tl = tt + 512 * q + tid; wq[q] = (tl < SEQ) ? SEL[(size_t)(b * SEQ + tl) * 8 + h] : 0xffffffffu; }
#pragma unroll
            for (int q = 0; q < 4; ++q) {
                const int tl = tt + 512 * q + tid; const unsigned w = wq[q];
                const int n = ((w & 0xffu) == (unsigned)j) ? 0 : (((w >> 8) & 0xffu) == (unsigned)j) ? 1 : (((w >> 16) & 0xffu) == (unsigned)j) ? 2 : -1;
                const unsigned long long mk = __ballot(n >= 0);
                const int np = __popcll(mk);
                unsigned base = 0u;
                if (lane == 0 && np) base = lds_add(CNT, (unsigned)np);
                base = __shfl(base, 0);
                if (n >= 0) { const int rk = __popcll(mk & ((1ull << lane) - 1ull)); LIST[base + rk] = (unsigned short)((tl << 2) | n); }
            }
        }
        __syncthreads();
        cnt = (int)*CNT;
    }
    const int nitems = (cnt + 15) >> 4, ql = lane & 15, g = lane >> 4;
#define ATT_ITEM(r_) (own ? ((r_) >= 2 ? -1 : ((r_) ? 15 - wave : wave)) : ((wave + 8 * (r_) < nitems) ? wave + 8 * (r_) : -1))
#define ATT_FETCH(it_, entry_, valid_, q0_, q1_) do { const int e_ = (it_) * 16 + ql; valid_ = e_ < cnt; \
        if (own) entry_ = (unsigned)(((j * 256 + e_) << 2) | 3); else entry_ = LIST[valid_ ? e_ : (it_) * 16]; \
        const bf16* qrow_ = QR + ((size_t)bh * SEQ + (int)(entry_ >> 2)) * 64; q0_ = *(const bf16x8*)(qrow_ + 8 * g); q1_ = *(const bf16x8*)(qrow_ + 32 + 8 * g); } while (0)
    int itn = ATT_ITEM(0); unsigned entn = 0u; bool validn = false; bf16x8 qn0 = {}, qn1 = {};
    if (itn >= 0) ATT_FETCH(itn, entn, validn, qn0, qn1);
    for (int r = 0; itn >= 0; ++r) {
        const int it = itn; const unsigned entry = entn; const bool valid = validn; const bf16x8 qf0 = qn0, qf1 = qn1;
        itn = ATT_ITEM(r + 1);
        if (itn >= 0) ATT_FETCH(itn, entn, validn, qn0, qn1);
        const int tl = (int)(entry >> 2), slot = (int)(entry & 3u);
        const int ntile = own ? it + 1 : 16;
        f32x4 sc[16];
#pragma unroll
        for (int n2 = 0; n2 < 16; ++n2) {
            if (n2 < ntile) {
                const int key = 16 * n2 + ql, sw = (key >> 1) & 7;
                const bf16x8 a0 = *(const LAS bf16x8*)(KS + key * 128 + ((g ^ sw) << 4)), a1 = *(const LAS bf16x8*)(KS + key * 128 + (((4 + g) ^ sw) << 4));
                f32x4 a = __builtin_amdgcn_mfma_f32_16x16x32_bf16(a0, qf0, (f32x4){0.f, 0.f, 0.f, 0.f}, 0, 0, 0);
                sc[n2] = __builtin_amdgcn_mfma_f32_16x16x32_bf16(a1, qf1, a, 0, 0, 0);
            } else sc[n2] = (f32x4){-__builtin_inff(), -__builtin_inff(), -__builtin_inff(), -__builtin_inff()};
        }
        if (own) {
#pragma unroll
            for (int n2 = 0; n2 < 16; ++n2) if (n2 == it) {
#pragma unroll
                for (int rg = 0; rg < 4; ++rg) if (4 * g + rg > ql) sc[n2][rg] = -__builtin_inff();
            }
        }
        float mx = -__builtin_inff();
#pragma unroll
        for (int n2 = 0; n2 < 16; ++n2) mx = fmaxf(mx, fmaxf(fmaxf(sc[n2][0], sc[n2][1]), fmaxf(sc[n2][2], sc[n2][3])));
        mx = fmaxf(mx, __shfl_xor(mx, 16)); mx = fmaxf(mx, __shfl_xor(mx, 32));
        float ls = 0.f;
#pragma unroll
        for (int n2 = 0; n2 < 16; ++n2) {
#pragma unroll
            for (int rg = 0; rg < 4; ++rg) { const float p = __expf(sc[n2][rg] - mx); sc[n2][rg] = p; ls += p; }
        }
        ls += __shfl_xor(ls, 16); ls += __shfl_xor(ls, 32);
        f32x4 o[4];
#pragma unroll
        for (int dt = 0; dt < 4; ++dt) o[dt] = (f32x4){0.f, 0.f, 0.f, 0.f};
#pragma unroll
        for (int s2 = 0; s2 < 8; ++s2) {
            if (2 * s2 < ntile) {
                v4u pw; pw.x = pg8::cvt_pk_bf16(sc[2 * s2][0], sc[2 * s2][1]); pw.y = pg8::cvt_pk_bf16(sc[2 * s2][2], sc[2 * s2][3]);
                pw.z = pg8::cvt_pk_bf16(sc[2 * s2 + 1][0], sc[2 * s2 + 1][1]); pw.w = pg8::cvt_pk_bf16(sc[2 * s2 + 1][2], sc[2 * s2 + 1][3]);
                const bf16x8 pf = __builtin_bit_cast(bf16x8, pw);
#pragma unroll
                for (int dt = 0; dt < 4; ++dt) { const int d = 16 * dt + ql;
                    const bf16x8 va = *(const LAS bf16x8*)(VS + d * 512 + (((4 * s2 + g) ^ (d & 15)) << 4));
                    o[dt] = __builtin_amdgcn_mfma_f32_16x16x32_bf16(va, pf, o[dt], 0, 0, 0); }
            }
        }
        if (valid) {
            const float inv = 1.0f / ls;
            const size_t pair = ((size_t)(b * SEQ + tl) * 8 + h) * 4 + slot;
#pragma unroll
            for (int dt = 0; dt < 4; ++dt) { v2u w; w.x = pg8::cvt_pk_bf16(o[dt][0] * inv, o[dt][1] * inv); w.y = pg8::cvt_pk_bf16(o[dt][2] * inv, o[dt][3] * inv);
                *(v2u*)(PO + pair * 64 + 16 * dt + 4 * g) = w; }
            if (g == 0) { PM[pair] = mx; PL[pair] = ls; }
        }
    }
}

__device__ __forceinline__ void phase_p5_merge(unsigned char* ws, int gw, int NGW, int lane) {
    const unsigned* SEL = (const unsigned*)(ws + WS_SEL); const bf16* PO = (const bf16*)(ws + WS_PO); const float* PM = (const float*)(ws + WS_PM); const float* PL = (const float*)(ws + WS_PL);
    bf16* YB = (bf16*)(ws + WS_YB);
    const int h = lane >> 3, part = lane & 7;
    for (int t0 = gw * 4; t0 < T; t0 += NGW * 4) {
        unsigned w[4]; float m0[4], m1[4], m2[4], m3[4], l0[4], l1[4], l2[4], l3[4]; bool v0[4], v1[4], v2[4];
#pragma unroll
        for (int q = 0; q < 4; ++q) { w[q] = SEL[(size_t)(t0 + q) * 8 + h]; v0[q] = (w[q] & 0xffu) != 255u; v1[q] = ((w[q] >> 8) & 0xffu) != 255u; v2[q] = ((w[q] >> 16) & 0xffu) != 255u;
        }
        const float NI = -__builtin_inff();
#pragma unroll
        for (int q = 0; q < 4; ++q) { const size_t pb = ((size_t)(t0 + q) * 8 + h) * 4;
            const f32x4 pm = *(const f32x4*)(PM + pb), pl = *(const f32x4*)(PL + pb);
            m0[q] = v0[q] ? pm[0] : NI; m1[q] = v1[q] ? pm[1] : NI; m2[q] = v2[q] ? pm[2] : NI; m3[q] = pm[3];
            l0[q] = v0[q] ? pl[0] : 0.f; l1[q] = v1[q] ? pl[1] : 0.f; l2[q] = v2[q] ? pl[2] : 0.f; l3[q] = pl[3]; }
        v4u p0[4], p1[4], p2[4], p3[4];
#pragma unroll
        for (int q = 0; q < 4; ++q) { const size_t pb = ((size_t)(t0 + q) * 8 + h) * 4; const v4u z = {0u, 0u, 0u, 0u};
            const v4u r0 = *(const v4u*)(PO + (pb + 0) * 64 + part * 8), r1 = *(const v4u*)(PO + (pb + 1) * 64 + part * 8), r2 = *(const v4u*)(PO + (pb + 2) * 64 + part * 8);
            p0[q] = v0[q] ? r0 : z; p1[q] = v1[q] ? r1 : z; p2[q] = v2[q] ? r2 : z; p3[q] = *(const v4u*)(PO + (pb + 3) * 64 + part * 8); }
#pragma unroll
        for (int q = 0; q < 4; ++q) {
            const float ms = fmaxf(fmaxf(m0[q], m1[q]), fmaxf(m2[q], m3[q]));
            float a0 = v0[q] ? l0[q] * __expf(m0[q] - ms) : 0.f, a1 = v1[q] ? l1[q] * __expf(m1[q] - ms) : 0.f, a2 = v2[q] ? l2[q] * __expf(m2[q] - ms) : 0.f, a3 = l3[q] * __expf(m3[q] - ms);
            const float inv = 1.0f / (((a0 + a1) + a2) + a3); a0 *= inv; a1 *= inv; a2 *= inv; a3 *= inv;
            float acc[8];
#define MRG(e, f, c_) acc[e] = a0 * f(p0[q].c_) + a1 * f(p1[q].c_) + a2 * f(p2[q].c_) + a3 * f(p3[q].c_)
            MRG(0, bflo, x); MRG(1, bfhi, x); MRG(2, bflo, y); MRG(3, bfhi, y); MRG(4, bflo, z); MRG(5, bfhi, z); MRG(6, bflo, w); MRG(7, bfhi, w);
#undef MRG
            v4u o; o.x = pk2(acc[0], acc[1]); o.y = pk2(acc[2], acc[3]); o.z = pk2(acc[4], acc[5]); o.w = pk2(acc[6], acc[7]);
            *(v4u*)(YB + (size_t)(t0 + q) * 1024 + h * 64 + part * 8) = o;
        }
    }
}


constexpr int WY_WRB = 18432;
constexpr int WY_TA = 0, WY_TB = 2304, WY_TK = 4608, WY_TR = 6912;
constexpr int WY_CB = 9216, WY_CK = 11264, WY_VT = 13312;
constexpr int WY_PK = 15360, WY_PRB = 15872, WY_PRK = 16384;
constexpr int WY_GC = 16896, WY_BON = 17152;

__device__ __forceinline__ bf16x8 frag_lo(v2u lo) { v4u w; w.x = lo.x; w.y = lo.y; w.z = 0u; w.w = 0u; return __builtin_bit_cast(bf16x8, w); }
__device__ __forceinline__ bf16x8 frag_2(v2u a, v2u b) { v4u w; w.x = a.x; w.y = a.y; w.z = b.x; w.w = b.y; return __builtin_bit_cast(bf16x8, w); }
__device__ __forceinline__ v2u pack4(const f32x4 v) { v2u w; w.x = pg8::cvt_pk_bf16(v[0], v[1]); w.y = pg8::cvt_pk_bf16(v[2], v[3]); return w; }
#define WY_MFMA(a, b, c) __builtin_amdgcn_mfma_f32_16x16x32_bf16(a, b, c, 0, 0, 0)

template <bool WITHV, bool WITHY>
__device__ __forceinline__ void wy_prep(LAS unsigned char* wl, const float* PRE, const float* PREV, int t0, int h, int lane, float rk, float kkc, float kac) {
    asm volatile("" : "+v"(lane));
    float kkv[16], wv[16], bv[16], kpv[16], rv[16], vt[16];
    const float* pre0 = PRE + ((size_t)t0 * 8 + h) * 320; const float* pv0 = PREV + (size_t)t0 * 512 + h * 64;
    const unsigned ul = (unsigned)lane;
#pragma unroll
    for (int t = 0; t < 16; ++t) { kkv[t] = (pre0 + (t * 2560 + 192))[ul]; wv[t] = (pre0 + (t * 2560 + 64))[ul]; bv[t] = (pre0 + (t * 2560 + 128))[ul];
        if (WITHV) vt[t] = (pv0 + t * 512)[ul];
        if (WITHY) rv[t] = (pre0 + (t * 2560 + 256))[ul]; }
    {
        float n2[16], q8[8], q4[4], q2[2], q1;
#pragma unroll
        for (int t = 0; t < 16; ++t) { const float x = kkv[t] * kkc; n2[t] = x * x; }
        { const bool hi = (lane & 32) != 0;
#pragma unroll
          for (int i = 0; i < 8; ++i) { const float keep = hi ? n2[i + 8] : n2[i], send = hi ? n2[i] : n2[i + 8]; q8[i] = keep + __shfl_xor(send, 32); } }
        { const bool hi = (lane & 16) != 0;
#pragma unroll
          for (int i = 0; i < 4; ++i) { const float keep = hi ? q8[i + 4] : q8[i], send = hi ? q8[i] : q8[i + 4]; q4[i] = keep + __shfl_xor(send, 16); } }
        { const bool hi = (lane & 8) != 0;
#pragma unroll
          for (int i = 0; i < 2; ++i) { const float keep = hi ? q4[i + 2] : q4[i], send = hi ? q4[i] : q4[i + 2]; q2[i] = keep + __shfl_xor(send, 8); } }
        { const bool hi = (lane & 4) != 0; const float keep = hi ? q2[1] : q2[0], send = hi ? q2[0] : q2[1]; q1 = keep + __shfl_xor(send, 4); }
        q1 += __shfl_xor(q1, 2); q1 += __shfl_xor(q1, 1);
#pragma unroll
        for (int t = 0; t < 16; ++t) {
            const float nn = __builtin_bit_cast(float, __builtin_amdgcn_readlane(__builtin_bit_cast(int, q1), ((t >> 3) & 1) * 32 + ((t >> 2) & 1) * 16 + ((t >> 1) & 1) * 8 + (t & 1) * 4));
            const float k = kkv[t], a = bv[t];
            const float kk = (k * kkc) / fmaxf(sqrtf(nn), 1e-12f);
            kkv[t] = kk; bv[t] = kk * a; if (WITHV) kpv[t] = k * (1.0f + (a - 1.0f) * kac);
        }
    }
    float gam = 1.f, pb[16];
#pragma unroll
    for (int t = 0; t < 16; ++t) {
        const float gp = gam; gam *= wv[t]; const float ig = __builtin_amdgcn_rcpf(gam);
        if (WITHY) pb[t] = rv[t] * kpv[t] * rk;
        bv[t] *= ig;
        *(LAS unsigned short*)(wl + WY_TA + t * 144 + lane * 2) = (unsigned short)f2bf(-gp * kkv[t]);
        *(LAS unsigned short*)(wl + WY_TB + t * 144 + lane * 2) = (unsigned short)f2bf(bv[t]);
        if (WITHV) { kpv[t] *= ig; *(LAS unsigned short*)(wl + WY_TK + t * 144 + lane * 2) = (unsigned short)f2bf(kpv[t]); }
        if (WITHY) *(LAS unsigned short*)(wl + WY_TR + t * 144 + lane * 2) = (unsigned short)f2bf(gam * rv[t]);
    }
    if (WITHY) {
        float q8[8], q4[4], q2[2], q1;
        { const bool hi = (lane & 32) != 0;
#pragma unroll
          for (int i = 0; i < 8; ++i) { const float keep = hi ? pb[i + 8] : pb[i], send = hi ? pb[i] : pb[i + 8]; q8[i] = keep + __shfl_xor(send, 32); } }
        { const bool hi = (lane & 16) != 0;
#pragma unroll
          for (int i = 0; i < 4; ++i) { const float keep = hi ? q8[i + 4] : q8[i], send = hi ? q8[i] : q8[i + 4]; q4[i] = keep + __shfl_xor(send, 16); } }
        { const bool hi = (lane & 8) != 0;
#pragma unroll
          for (int i = 0; i < 2; ++i) { const float keep = hi ? q4[i + 2] : q4[i], send = hi ? q4[i] : q4[i + 2]; q2[i] = keep + __shfl_xor(send, 8); } }
        { const bool hi = (lane & 4) != 0; const float keep = hi ? q2[1] : q2[0], send = hi ? q2[0] : q2[1]; q1 = keep + __shfl_xor(send, 4); }
        q1 += __shfl_xor(q1, 2); q1 += __shfl_xor(q1, 1);
        const int tk = ((lane >> 5) & 1) * 8 + ((lane >> 4) & 1) * 4 + ((lane >> 3) & 1) * 2 + ((lane >> 2) & 1);
        if ((lane & 3) == 0) *(LAS float*)(wl + WY_BON + tk * 4) = q1;
    }
    *(LAS float*)(wl + WY_GC + lane * 4) = gam;
    v4u o0, o1;
    o0.x = pk2(bv[0] * gam, bv[1] * gam); o0.y = pk2(bv[2] * gam, bv[3] * gam); o0.z = pk2(bv[4] * gam, bv[5] * gam); o0.w = pk2(bv[6] * gam, bv[7] * gam);
    o1.x = pk2(bv[8] * gam, bv[9] * gam); o1.y = pk2(bv[10] * gam, bv[11] * gam); o1.z = pk2(bv[12] * gam, bv[13] * gam); o1.w = pk2(bv[14] * gam, bv[15] * gam);
    *(LAS v4u*)(wl + WY_CB + lane * 32) = o0; *(LAS v4u*)(wl + WY_CB + lane * 32 + 16) = o1;
    if (WITHV) {
        o0.x = pk2(kpv[0] * gam, kpv[1] * gam); o0.y = pk2(kpv[2] * gam, kpv[3] * gam); o0.z = pk2(kpv[4] * gam, kpv[5] * gam); o0.w = pk2(kpv[6] * gam, kpv[7] * gam);
        o1.x = pk2(kpv[8] * gam, kpv[9] * gam); o1.y = pk2(kpv[10] * gam, kpv[11] * gam); o1.z = pk2(kpv[12] * gam, kpv[13] * gam); o1.w = pk2(kpv[14] * gam, kpv[15] * gam);
        *(LAS v4u*)(wl + WY_CK + lane * 32) = o0; *(LAS v4u*)(wl + WY_CK + lane * 32 + 16) = o1;
        o0.x = pk2(vt[0], vt[1]); o0.y = pk2(vt[2], vt[3]); o0.z = pk2(vt[4], vt[5]); o0.w = pk2(vt[6], vt[7]);
        o1.x = pk2(vt[8], vt[9]); o1.y = pk2(vt[10], vt[11]); o1.z = pk2(vt[12], vt[13]); o1.w = pk2(vt[14], vt[15]);
        *(LAS v4u*)(wl + WY_VT + lane * 32) = o0; *(LAS v4u*)(wl + WY_VT + lane * 32 + 16) = o1;
    }
    LDS_WAIT(); asm volatile("" ::: "memory");
}
__device__ __forceinline__ bf16x8 wy_nat(const LAS unsigned char* img, int ql, int g, int s) { return *(const LAS bf16x8*)(img + ql * 144 + 64 * s + 16 * g); }
__device__ __forceinline__ bf16x8 wy_perm(const LAS unsigned char* img, int ql, int g, int s) {
    return frag_2(*(const LAS v2u*)(img + ql * 144 + 64 * s + 8 * g), *(const LAS v2u*)(img + ql * 144 + 64 * s + 32 + 8 * g)); }
__device__ __forceinline__ bf16x8 wy_tok4(const LAS unsigned char* img, int row, int g) { return frag_lo(*(const LAS v2u*)(img + row * 32 + 8 * g)); }
template <int I> __device__ __forceinline__ void wy_solve(float (&z)[4][4], const float (&pab)[4], int ql) {
    if constexpr (I < 15) {
        float u[4];
#pragma unroll
        for (int ct = 0; ct < 4; ++ct) u[ct] = __shfl(z[ct][I & 3], ql + 16 * (I >> 2));
        asm volatile("s_nop 1");
#pragma unroll
        for (int ct = 0; ct < 4; ++ct) {
            fmac_bc<I>(z[ct][0], pab[0], u[ct]); fmac_bc<I>(z[ct][1], pab[1], u[ct]); fmac_bc<I>(z[ct][2], pab[2], u[ct]); fmac_bc<I>(z[ct][3], pab[3], u[ct]); }
        wy_solve<I + 1>(z, pab, ql);
    }
}
template <bool WITHV, bool WITHY>
__device__ __forceinline__ void wy_block(f32x4 (&acc)[4][4], f32x4 (&y)[4], LAS unsigned char* wl, int lane) {
    asm volatile("" : "+v"(lane));
    const int ql = lane & 15, g = lane >> 4;
    const f32x4 zero4 = {0.f, 0.f, 0.f, 0.f};
    f32x4 pab = zero4;
    {
        const bf16x8 a0 = wy_nat(wl + WY_TA, ql, g, 0), a1 = wy_nat(wl + WY_TA, ql, g, 1), b0 = wy_nat(wl + WY_TB, ql, g, 0), b1 = wy_nat(wl + WY_TB, ql, g, 1);
        pab = WY_MFMA(a0, b0, pab); pab = WY_MFMA(a1, b1, pab);
#pragma unroll
        for (int r = 0; r < 4; ++r) pab[r] = (4 * g + r > ql) ? pab[r] : 0.f;
        if (WITHV) {
            const bf16x8 k0 = wy_nat(wl + WY_TK, ql, g, 0), k1 = wy_nat(wl + WY_TK, ql, g, 1);
            f32x4 p = WY_MFMA(a0, k0, zero4); p = WY_MFMA(a1, k1, p);
#pragma unroll
            for (int r = 0; r < 4; ++r) *(LAS unsigned short*)(wl + WY_PK + (4 * g + r) * 32 + ql * 2) = (unsigned short)f2bf((4 * g + r > ql) ? p[r] : 0.f);
            if (WITHY) {
                const bf16x8 r0 = wy_nat(wl + WY_TR, ql, g, 0), r1 = wy_nat(wl + WY_TR, ql, g, 1);
                f32x4 q = WY_MFMA(r0, b0, zero4); q = WY_MFMA(r1, b1, q);
#pragma unroll
                for (int r = 0; r < 4; ++r) *(LAS unsigned short*)(wl + WY_PRB + (4 * g + r) * 32 + ql * 2) = (unsigned short)f2bf((4 * g + r >= ql) ? q[r] : 0.f);
                q = WY_MFMA(r0, k0, zero4); q = WY_MFMA(r1, k1, q);
#pragma unroll
                for (int r = 0; r < 4; ++r) *(LAS unsigned short*)(wl + WY_PRK + (4 * g + r) * 32 + ql * 2) = (unsigned short)f2bf((4 * g + r >= ql) ? q[r] : 0.f);
            }
        }
    }
    bf16x8 hf[2][4];
#pragma unroll
    for (int s = 0; s < 2; ++s)
#pragma unroll
        for (int ct = 0; ct < 4; ++ct) hf[s][ct] = frag_2(pack4(acc[2 * s][ct]), pack4(acc[2 * s + 1][ct]));
    LDS_WAIT(); asm volatile("" ::: "memory");
    f32x4 z[4];
    bf16x8 vf[4];
    {
        const bf16x8 a0 = wy_perm(wl + WY_TA, ql, g, 0), a1 = wy_perm(wl + WY_TA, ql, g, 1);
#pragma unroll
        for (int ct = 0; ct < 4; ++ct) { z[ct] = WY_MFMA(a0, hf[0][ct], zero4); z[ct] = WY_MFMA(a1, hf[1][ct], z[ct]); }
        if (WITHV) {
            const bf16x8 pk = wy_tok4(wl + WY_PK, ql, g);
#pragma unroll
            for (int ct = 0; ct < 4; ++ct) { vf[ct] = wy_tok4(wl + WY_VT, 16 * ct + ql, g); z[ct] = WY_MFMA(pk, vf[ct], z[ct]); }
        }
    }
    bf16x8 uf[4];
    {
        float zf[4][4], pf[4];
#pragma unroll
        for (int ct = 0; ct < 4; ++ct)
#pragma unroll
            for (int r = 0; r < 4; ++r) zf[ct][r] = z[ct][r];
#pragma unroll
        for (int r = 0; r < 4; ++r) pf[r] = pab[r];
        wy_solve<0>(zf, pf, ql);
#pragma unroll
        for (int ct = 0; ct < 4; ++ct) { v2u w; w.x = pg8::cvt_pk_bf16(zf[ct][0], zf[ct][1]); w.y = pg8::cvt_pk_bf16(zf[ct][2], zf[ct][3]); uf[ct] = frag_lo(w); }
    }
    if (WITHY) {
        const bf16x8 r0 = wy_perm(wl + WY_TR, ql, g, 0), r1 = wy_perm(wl + WY_TR, ql, g, 1), prb = wy_tok4(wl + WY_PRB, ql, g), prk = wy_tok4(wl + WY_PRK, ql, g);
#pragma unroll
        for (int ct = 0; ct < 4; ++ct) { y[ct] = WY_MFMA(r0, hf[0][ct], zero4); y[ct] = WY_MFMA(r1, hf[1][ct], y[ct]); y[ct] = WY_MFMA(prb, uf[ct], y[ct]); y[ct] = WY_MFMA(prk, vf[ct], y[ct]); }
    }
#pragma unroll
    for (int rt = 0; rt < 4; ++rt) {
        const f32x4 gc = *(const LAS f32x4*)(wl + WY_GC + (16 * rt + 4 * g) * 4);
        const bf16x8 bb = wy_tok4(wl + WY_CB, 16 * rt + ql, g);
        bf16x8 kb; if (WITHV) kb = wy_tok4(wl + WY_CK, 16 * rt + ql, g);
#pragma unroll
        for (int ct = 0; ct < 4; ++ct) { f32x4 a = acc[rt][ct] * gc; a = WY_MFMA(bb, uf[ct], a); if (WITHV) a = WY_MFMA(kb, vf[ct], a); acc[rt][ct] = a; }
    }
}

template <bool TYPE1>
__device__ __forceinline__ void wy_summary(unsigned char* ws, float* MN, const float* PREV, LAS unsigned char* wl, int bh, int ch, int lane, const float* k_k, const float* k_a) {
    const float* PRE = (const float*)(ws + WS_PRE);
    const float kkc = k_k[(bh & 7) * 64 + lane], kac = k_a[(bh & 7) * 64 + lane];
    const int ql = lane & 15, g = lane >> 4, b = bh >> 3, h = bh & 7, t0 = b * SEQ + ch * RCH;
    f32x4 acc[4][4], y[4];
#pragma unroll
    for (int rt = 0; rt < 4; ++rt)
#pragma unroll
        for (int ct = 0; ct < 4; ++ct)
#pragma unroll
            for (int r = 0; r < 4; ++r) acc[rt][ct][r] = (!TYPE1 && rt == ct && (4 * g + r == ql)) ? 1.f : 0.f;
    for (int blk = 0; blk < RCH / 16; ++blk) { wy_prep<TYPE1, false>(wl, PRE, PREV, t0 + 16 * blk, h, lane, 0.f, kkc, kac); wy_block<TYPE1, false>(acc, y, wl, lane); }
    float* dst = MN + ((size_t)(bh * NCH + ch) * 2 + (TYPE1 ? 1 : 0)) * 4096 + (TYPE1 ? (ql * 64 + 4 * g) : (4 * g * 64 + ql));
    asm volatile("" : "+v"(dst));
#pragma unroll
    for (int rt = 0; rt < 4; ++rt)
#pragma unroll
        for (int ct = 0; ct < 4; ++ct) {
            if (TYPE1) *(f32x4*)(dst + (16 * ct) * 64 + 16 * rt) = acc[rt][ct];
            else {
#pragma unroll
                for (int r = 0; r < 4; ++r) dst[(16 * rt + r) * 64 + 16 * ct] = acc[rt][ct][r];
            }
        }
}
__device__ __forceinline__ void phase_p3_wy(unsigned char* ws, float* MN, const float* PREV, const float* k_k, const float* k_a, LAS unsigned char* lds, int gw, int NGW, int wave, int lane) {
    LAS unsigned char* wl = lds + wave * WY_WRB;
    for (int it = gw; it < 16 * NCH * 2; it += NGW) {
        const int type = __builtin_amdgcn_readfirstlane(it & 1), ch = __builtin_amdgcn_readfirstlane((it >> 1) & (NCH - 1)), bh = __builtin_amdgcn_readfirstlane(it >> 8);
        if (type) wy_summary<true>(ws, MN, PREV, wl, bh, ch, lane, k_k, k_a); else wy_summary<false>(ws, MN, PREV, wl, bh, ch, lane, k_k, k_a);
    }
}
__device__ __forceinline__ void phase_p5_rwkv_wy(unsigned char* ws, const float* PREV, const float* G, const float* r_k, const float* lnx_g, const float* lnx_b, const float* k_k, const float* k_a, LAS unsigned char* lds, int gw, int NGW, int wave, int lane) {
    const float* PRE = (const float*)(ws + WS_PRE); const float* HC = (const float*)(ws + WS_HC); bf16* YB = (bf16*)(ws + WS_YB);
    LAS unsigned char* wl = lds + wave * WY_WRB;
    const int ql = lane & 15, g = lane >> 4;
    for (int it = gw; it < 16 * NCH; it += NGW) {
        const int ch = __builtin_amdgcn_readfirstlane(it & (NCH - 1)), bh = __builtin_amdgcn_readfirstlane(it >> 7), b = bh >> 3, h = bh & 7;
        const int t0 = b * SEQ + ch * RCH;
        f32x4 acc[4][4], y[4];
        const float* src = HC + (size_t)(bh * NCH + ch) * 4096 + ql * 64 + 4 * g;
        asm volatile("" : "+v"(src));
#pragma unroll
        for (int rt = 0; rt < 4; ++rt)
#pragma unroll
            for (int ct = 0; ct < 4; ++ct) acc[rt][ct] = *(const f32x4*)(src + (16 * ct) * 64 + 16 * rt);
        const float rk = r_k[h * 64 + lane], kkc = k_k[h * 64 + lane], kac = k_a[h * 64 + lane];
        float lg[4], lb[4];
#pragma unroll
        for (int ct = 0; ct < 4; ++ct) { lg[ct] = lnx_g[h * 64 + 16 * ct + ql]; lb[ct] = lnx_b[h * 64 + 16 * ct + ql]; }
        for (int blk = 0; blk < RCH / 16; ++blk) {
            const int tb = t0 + 16 * blk;
            wy_prep<true, true>(wl, PRE, PREV, tb, h, lane, rk, kkc, kac);
            float vv[4][4], gg[4][4];
            {
                const float* pvb = PREV + (size_t)tb * 512 + h * 64; const float* pgb = G + (size_t)tb * 512 + h * 64;
                const unsigned eo = (unsigned)(4 * g * 512 + ql);
#pragma unroll
                for (int r = 0; r < 4; ++r)
#pragma unroll
                    for (int ct = 0; ct < 4; ++ct) { vv[r][ct] = (pvb + (r * 512 + 16 * ct))[eo]; gg[r][ct] = (pgb + (r * 512 + 16 * ct))[eo]; }
            }
            wy_block<true, true>(acc, y, wl, lane);
#pragma unroll
            for (int r = 0; r < 4; ++r) {
                float s = (y[0][r] + y[1][r]) + (y[2][r] + y[3][r]);
                s += __shfl_xor(s, 1); s += __shfl_xor(s, 2); s += __shfl_xor(s, 4); s += __shfl_xor(s, 8);
                const float mean = s * (1.0f / 64.0f);
                float d[4], q = 0.f;
#pragma unroll
                for (int ct = 0; ct < 4; ++ct) { d[ct] = y[ct][r] - mean; q += d[ct] * d[ct]; }
                q += __shfl_xor(q, 1); q += __shfl_xor(q, 2); q += __shfl_xor(q, 4); q += __shfl_xor(q, 8);
                const float rstd = rsqrtf(q * (1.0f / 64.0f) + GN_EPS);
                const float bn = *(const LAS float*)(wl + WY_BON + (4 * g + r) * 4);
                bf16* yb = YB + (size_t)tb * 1024 + 512 + h * 64; const unsigned yo = (unsigned)((4 * g + r) * 1024 + ql);
#pragma unroll
                for (int ct = 0; ct < 4; ++ct) (yb + 16 * ct)[yo] = (bf16)f2bf((d[ct] * rstd * lg[ct] + lb[ct] + bn * vv[r][ct]) * gg[r][ct]);
            }
        }
    }
}

constexpr int WRS2 = 2064;
__device__ __forceinline__ void phase_p8(const float* PRE1, const float* ln_g, const float* ln_b, const float* w_router, const float* b_router,
                                         unsigned char* ws, LAS unsigned char* lds, LAS unsigned* hist, int blk, int G, int tid, int wave, int lane, bool count) {
    LAS unsigned char* whi = lds; LAS unsigned char* wlo = lds + 32 * WRS2;
    for (int i0 = 0; i0 < 64; i0 += 16) {
        float wv[16];
#pragma unroll
        for (int i = 0; i < 16; ++i) wv[i] = w_router[tid + NTHR * (i0 + i)];
#pragma unroll
        for (int i = 0; i < 16; ++i) { const int idx = tid + NTHR * (i0 + i); const float w = wv[i]; const unsigned h = f2bf(w); const unsigned l = f2bf(w - bf2f(h));
            const int e = idx & 31, k = idx >> 5; *(LAS unsigned short*)(whi + e * WRS2 + k * 2) = (unsigned short)h; *(LAS unsigned short*)(wlo + e * WRS2 + k * 2) = (unsigned short)l; }
    }
    if (tid < 32) hist[tid] = 0u;
    __syncthreads();
    bf16* HB = (bf16*)(ws + WS_HB); bf16* HBL = (bf16*)(ws + WS_XG); float* STATS = (float*)(ws + WS_STATS); int* TOPE = (int*)(ws + WS_TOPE); float* TOPG = (float*)(ws + WS_TOPG);
    const int ql = lane & 15, g = lane >> 4;
    f32x4 lg4[4], lb4[4];
#pragma unroll
    for (int j = 0; j < 4; ++j) { lg4[j] = *(const f32x4*)(ln_g + 256 * j + 4 * lane); lb4[j] = *(const f32x4*)(ln_b + 256 * j + 4 * lane); }
    for (int tb = (blk * NWAVES + wave) * 16; tb < T; tb += G * NWAVES * 16) {
        for (int q0 = 0; q0 < 16; q0 += 4) {
            f32x4 x[4][4];
#pragma unroll
            for (int q = 0; q < 4; ++q)
#pragma unroll
                for (int j = 0; j < 4; ++j) x[q][j] = *(const f32x4*)(PRE1 + (size_t)(tb + q0 + q) * 1024 + 256 * j + 4 * lane);
#pragma unroll
            for (int q = 0; q < 4; ++q) {
                const int t = tb + q0 + q; float s = 0.f;
#pragma unroll
                for (int j = 0; j < 4; ++j) s += (x[q][j][0] + x[q][j][1]) + (x[q][j][2] + x[q][j][3]);
                const float mean = wave_sum(s) * (1.0f / 1024.0f); float s2 = 0.f;
#pragma unroll
                for (int j = 0; j < 4; ++j) { x[q][j] = x[q][j] - mean; s2 += (x[q][j][0] * x[q][j][0] + x[q][j][1] * x[q][j][1]) + (x[q][j][2] * x[q][j][2] + x[q][j][3] * x[q][j][3]); }
                const float rstd = rsqrtf(wave_sum(s2) * (1.0f / 1024.0f) + LN_EPS);
                if (lane == 0) { STATS[(size_t)t * 2] = mean; STATS[(size_t)t * 2 + 1] = rstd; }
#pragma unroll
                for (int j = 0; j < 4; ++j) { const f32x4 hh = x[q][j] * rstd * lg4[j] + lb4[j];
                    v2u hi; hi.x = pk2(hh[0], hh[1]); hi.y = pk2(hh[2], hh[3]);
                    v2u lo; lo.x = pk2(hh[0] - bflo(hi.x), hh[1] - bfhi(hi.x)); lo.y = pk2(hh[2] - bflo(hi.y), hh[3] - bfhi(hi.y));
                    *(v2u*)(HB + (size_t)t * 1024 + 256 * j + 4 * lane) = hi; *(v2u*)(HBL + (size_t)t * 1024 + 256 * j + 4 * lane) = lo; }
            }
        }
        VM_WAIT();
        f32x4 acc0 = {0.f, 0.f, 0.f, 0.f}, acc1 = acc0;
        const bf16* arow = HB + (size_t)(tb + ql) * 1024 + 8 * g; const bf16* lrow = HBL + (size_t)(tb + ql) * 1024 + 8 * g;
        const LAS unsigned char* b0p = whi + ql * WRS2 + 16 * g; const LAS unsigned char* b1p = whi + (16 + ql) * WRS2 + 16 * g;
#pragma unroll 1
        for (int s0 = 0; s0 < 32; s0 += 8) {
            bf16x8 ah[8], al[8];
#pragma unroll
            for (int i = 0; i < 8; ++i) { ah[i] = *(const bf16x8*)(arow + 32 * (s0 + i)); al[i] = *(const bf16x8*)(lrow + 32 * (s0 + i)); }
#pragma unroll
            for (int i = 0; i < 8; ++i) {
                const int so = 64 * (s0 + i);
                const bf16x8 bh0 = *(const LAS bf16x8*)(b0p + so), bl0 = *(const LAS bf16x8*)(b0p + 32 * WRS2 + so), bh1 = *(const LAS bf16x8*)(b1p + so), bl1 = *(const LAS bf16x8*)(b1p + 32 * WRS2 + so);
                acc0 = __builtin_amdgcn_mfma_f32_16x16x32_bf16(ah[i], bh0, acc0, 0, 0, 0); acc0 = __builtin_amdgcn_mfma_f32_16x16x32_bf16(al[i], bh0, acc0, 0, 0, 0); acc0 = __builtin_amdgcn_mfma_f32_16x16x32_bf16(ah[i], bl0, acc0, 0, 0, 0);
                acc1 = __builtin_amdgcn_mfma_f32_16x16x32_bf16(ah[i], bh1, acc1, 0, 0, 0); acc1 = __builtin_amdgcn_mfma_f32_16x16x32_bf16(al[i], bh1, acc1, 0, 0, 0); acc1 = __builtin_amdgcn_mfma_f32_16x16x32_bf16(ah[i], bl1, acc1, 0, 0, 0);
            }
        }
        const float br0 = b_router[ql], br1 = b_router[16 + ql];
#pragma unroll
        for (int r = 0; r < 4; ++r) {
            float v0 = acc0[r] + br0, v1 = acc1[r] + br1; float tv[4]; int te[4];
#pragma unroll
            for (int rd = 0; rd < 4; ++rd) {
                float bv = (v0 >= v1) ? v0 : v1; int bi = (v0 >= v1) ? ql : 16 + ql;
#pragma unroll
                for (int off = 1; off < 16; off <<= 1) { const float ov = __shfl_xor(bv, off); const int oi = __shfl_xor(bi, off); const bool take = (ov > bv) || (ov == bv && oi < bi); bv = take ? ov : bv; bi = take ? oi : bi; }
                tv[rd] = bv; te[rd] = bi; if (bi == ql) v0 = -__builtin_inff(); if (bi == 16 + ql) v1 = -__builtin_inff();
            }
            const float e1 = __expf(tv[1] - tv[0]), e2 = __expf(tv[2] - tv[0]), e3 = __expf(tv[3] - tv[0]); const float inv = 1.0f / (((1.0f + e1) + e2) + e3);
            const float gsel = ql == 0 ? inv : ql == 1 ? e1 * inv : ql == 2 ? e2 * inv : e3 * inv;
            const int esel = ql == 0 ? te[0] : ql == 1 ? te[1] : ql == 2 ? te[2] : te[3];
            const int t = tb + 4 * g + r;
            if (ql < 4) { TOPE[(size_t)t * 4 + ql] = esel; TOPG[(size_t)t * 4 + ql] = gsel; lds_add(&hist[esel], 1u); }
        }
    }
    __syncthreads();
    if (count && tid < 32 && hist[tid]) atomicAdd((unsigned*)(ws + WS_CTL) + CW_ECNT + tid, hist[tid]);
}

__device__ __forceinline__ void phase_p9(const float* w1, const float* w2, unsigned char* ws, LAS unsigned char* lds, LAS unsigned* sm  , int blk, int G, int gw, int NGW, int tid, int wave, int lane) {
    unsigned* CTL = (unsigned*)(ws + WS_CTL);
    LAS unsigned* pstart = sm; LAS unsigned* lhist = sm + 32; LAS unsigned* lbase = sm + 64; LAS unsigned* slotOf = sm + 96;
    const int* TOPE = (const int*)(ws + WS_TOPE); const float* TOPG = (const float*)(ws + WS_TOPG); int* TOKSLOT = (int*)(ws + WS_TOKSLOT); float* SLOTG = (float*)(ws + WS_SLOTG);
    int* ROWIDX = (int*)(ws + WS_ROWIDX); int* TILEE = (int*)(ws + WS_TILEE);
    if (tid == 0) { unsigned acc = 0u; for (int e = 0; e < 32; ++e) { pstart[e] = acc; acc += ((CTL[CW_ECNT + e] + 255u) >> 8) << 8; }
        if (blk == 0) CTL[CW_NTILES] = acc >> 8; }
    __syncthreads();
    if (blk == 0) {
        for (int pm = tid; pm < NTILE_MAX; pm += NTHR) { const unsigned row = (unsigned)pm * 256u; int e = 0;
#pragma unroll 4
            for (int q = 1; q < 32; ++q) if (row >= pstart[q]) e = q;
            TILEE[pm] = e; }
    }
    for (int chunk = blk; chunk < T / 128; chunk += G) {
        if (tid < 32) lhist[tid] = 0u;
        __syncthreads();
        const int t = chunk * 128 + (tid >> 2), k = tid & 3; const int e = TOPE[(size_t)t * 4 + k];
        const unsigned rank = lds_add(&lhist[e], 1u);
        __syncthreads();
        if (tid < 32) lbase[tid] = lhist[tid] ? atomicAdd(&CTL[CW_ECUR + tid], lhist[tid]) : 0u;
        __syncthreads();
        const unsigned slot = pstart[e] + lbase[e] + rank;
        TOKSLOT[(size_t)t * 4 + k] = (int)slot; SLOTG[slot] = TOPG[(size_t)t * 4 + k]; ROWIDX[slot] = t;
        __syncthreads();
    }
    LAS float* scr = (LAS float*)(lds + wave * 16384);
    bf16* W1T = (bf16*)(ws + WS_W1T); bf16* W2T = (bf16*)(ws + WS_W2T);
    constexpr int I1 = 16 * 64, I2 = 16 * 32;
    REPS(10) for (int it = gw; it < NEXP * (I1 + I2); it += NGW) {
        if (it < NEXP * I1) { const int e = it / I1, r = it % I1; transpose_item<false>(w1 + (size_t)e * 1024 * 2048, 2048, W1T + (size_t)e * 2048 * 1024, 1024, 64 * (r / 64), 32 * (r % 64), 0, scr, lane); }
        else { const int r0 = it - NEXP * I1, e = r0 / I2, r = r0 % I2; transpose_item<false>(w2 + (size_t)e * 1024 * 1024, 1024, W2T + (size_t)e * 1024 * 1024, 1024, 64 * (r / 32), 32 * (r % 32), 0, scr, lane); }
    }
}

__device__ __forceinline__ void phase_final(float* OUT  , float* OUTW, const float* ln1_g, const float* ln1_b, const float* ln2_g, const float* ln2_b, unsigned char* ws, int gw, int NGW, int lane) {
    const float* STATS = (const float*)(ws + WS_STATS); const int* TOKSLOT = (const int*)(ws + WS_TOKSLOT); const bf16* YS = (const bf16*)(ws + WS_YS);
    f32x4 g1[4], b1[4], g2[4], b2[4];
#pragma unroll
    for (int j = 0; j < 4; ++j) { const int col = 256 * j + 4 * lane; g1[j] = *(const f32x4*)(ln1_g + col) * ALPHA; b1[j] = *(const f32x4*)(ln1_b + col) * ALPHA; g2[j] = *(const f32x4*)(ln2_g + col); b2[j] = *(const f32x4*)(ln2_b + col); }
    for (int t0 = gw * 2; t0 < T; t0 += NGW * 2) {
        float mean[2], rstd[2]; int sl[2][4]; f32x4 x[2][4]; v2u ys[2][4][4];
#pragma unroll
        for (int q = 0; q < 2; ++q) { const int t = t0 + q; mean[q] = STATS[(size_t)t * 2]; rstd[q] = STATS[(size_t)t * 2 + 1];
#pragma unroll
            for (int k = 0; k < 4; ++k) sl[q][k] = TOKSLOT[(size_t)t * 4 + k];
#pragma unroll
            for (int j = 0; j < 4; ++j) x[q][j] = __builtin_nontemporal_load((const f32x4*)(OUT + (size_t)t * 1024 + 256 * j + 4 * lane)); }
#pragma unroll
        for (int q = 0; q < 2; ++q)
#pragma unroll
            for (int k = 0; k < 4; ++k)
#pragma unroll
                for (int j = 0; j < 4; ++j) ys[q][k][j] = __builtin_nontemporal_load((const v2u*)(YS + (size_t)sl[q][k] * 1024 + 256 * j + 4 * lane));
#pragma unroll
        for (int q = 0; q < 2; ++q) {
            const int t = t0 + q; f32x4 z[4]; float s = 0.f;
#pragma unroll
            for (int j = 0; j < 4; ++j) {
                f32x4 h = (x[q][j] - mean[q]) * rstd[q] * g1[j] + b1[j];
                const v2u y0 = ys[q][0][j], y1 = ys[q][1][j], y2 = ys[q][2][j], y3 = ys[q][3][j];
                h[0] += (bflo(y0.x) + bflo(y1.x)) + (bflo(y2.x) + bflo(y3.x)); h[1] += (bfhi(y0.x) + bfhi(y1.x)) + (bfhi(y2.x) + bfhi(y3.x));
                h[2] += (bflo(y0.y) + bflo(y1.y)) + (bflo(y2.y) + bflo(y3.y)); h[3] += (bfhi(y0.y) + bfhi(y1.y)) + (bfhi(y2.y) + bfhi(y3.y));
                z[j] = h; s += (h[0] + h[1]) + (h[2] + h[3]); }
            const float m2 = wave_sum(s) * (1.0f / 1024.0f); float qq = 0.f;
#pragma unroll
            for (int j = 0; j < 4; ++j) { z[j] = z[j] - m2; qq += (z[j][0] * z[j][0] + z[j][1] * z[j][1]) + (z[j][2] * z[j][2] + z[j][3] * z[j][3]); }
            const float r2 = rsqrtf(wave_sum(qq) * (1.0f / 1024.0f) + LN_EPS);
#pragma unroll
            for (int j = 0; j < 4; ++j) __builtin_nontemporal_store(z[j] * r2 * g2[j] + b2[j], (f32x4*)(OUTW + (size_t)t * 1024 + 256 * j + 4 * lane));
        }
    }
}

#ifndef MK_PER_PHASE
#define MK_PER_PHASE 0
#endif
constexpr int NPHASE = 14;
struct Args { const float* in[26]; float* out; unsigned char* ws; int ph_lo, ph_hi; };

__global__ void __launch_bounds__(NTHR, 2) hybrid_fwd(Args args) {
    extern __shared__ __attribute__((aligned(16))) unsigned char lds_raw[];
    LAS unsigned char* lds = (LAS unsigned char*)lds_raw;
    volatile LAS unsigned* MISC = (volatile LAS unsigned*)(lds + MISC_OFF);
    const int tid = threadIdx.x, lane = tid & 63, wave = __builtin_amdgcn_readfirstlane(tid >> 6);
    const int G = gridDim.x, bx = blockIdx.x;
    const int vcu = (G % 8 == 0) ? (bx % 8) * (G / 8) + bx / 8 : bx;
    const int gw = vcu * NWAVES + wave, NGW = G * NWAVES;
    unsigned char* ws = args.ws;
    unsigned* CTL = (unsigned*)(ws + WS_CTL);
    for (int u = tid; u < (LDS_BYTES - MISC_OFF) / 4; u += NTHR) MISC[u] = 0u;
    __syncthreads();
    XcdBarrier bar; bar.bar = CTL + CW_BAR; bar.x = 0; bar.st = nullptr;
    if (!MK_PER_PHASE) bar = xcd_barrier_post(CTL + CW_BAR, MISC);
    const int lo = args.ph_lo, hi = args.ph_hi;
#ifndef PH_MASK
#define PH_MASK 0x3fff
#endif
#define IN(k) ((((PH_MASK) >> (k)) & 1) && lo <= (k) && (k) < hi)
#define SEAM(k) do { if (IN(k) && IN((k) + 1)) xcd_barrier(bar); } while (0)
#define RSH(k) (((REPEAT_MASK) >> (k)) & 1)
    const float* x = args.in[0];
    float* OUT = args.out;
    float* PREV = OUT;
    float* GG = OUT + (size_t)T * 512;

    if (IN(0)) REPS(0) { phase_p0(x, args.in[1], args.in[13], args.in[14], args.in[15], args.in[4], args.in[6], args.in[7], ws, lds, gw, NGW, wave, lane); }
    SEAM(0);
    if (IN(1)) {
        pg8::Gemm g{(const bf16*)(ws + WS_XB), (const bf16*)(ws + WS_WIN), 1024, 1024, 1024};
        GridOrder S; S.init(T / 256, NPROJ / 256, G, bx, 0u, RSH(1));
        EpiProj E{(bf16*)(ws + WS_QR), (bf16*)(ws + WS_KR), (bf16*)(ws + WS_VR), (bf16*)(ws + WS_SGA), (bf16*)(ws + WS_SGR), (float*)(ws + WS_KMEAN), (const float*)(ws + WS_ROPE),
                  (float*)(ws + WS_PRE), PREV, (float*)(ws + WS_RW), (float*)(ws + WS_RW) + (size_t)(T / 64) * 2048, (bf16*)(ws + WS_APR), args.in[2]};
        pg8::gemm_phase<EpiProj, GridOrder>(lds, g, S, E);
    }
    SEAM(1);
    if (IN(2)) { REPS(2) phase_p2_fix(args.in[2], ws, PREV, gw, NGW, lane); REPS(16) phase_p2_gate(ws, lds, gw, NGW, wave, lane); }
    SEAM(2);
    if (IN(3)) {
        pg8::Gemm g{(const bf16*)(ws + WS_APR), (const bf16*)(ws + WS_WLORA), 256, 512, 256};
        GridOrder S; S.init(T / 256, 6, G, bx, 128u, 0);
        EpiLora E{(float*)(ws + WS_PRE), GG, args.in[3], args.in[5]};
        pg8::gemm_phase<EpiLora, GridOrder>(lds, g, S, E);
    }
    SEAM(3);
    if (IN(4)) REPS(4) { phase_p3_wy(ws, (float*)(ws + WS_MN), PREV, args.in[8], args.in[9], lds, gw, NGW, wave, lane); }
    SEAM(4);
    if (IN(5)) {
        if (bx < 16) REPS(14) phase_p4_chain(ws, lds, bx, wave, lane);
        LAS unsigned* uq = (LAS unsigned*)(lds + 65536 + 32768 + 64);
        REPS(15) {
            unsigned nxt = 0u;
            if (tid == 0) nxt = atomicAdd(CTL + CW_ATTQ + rep, 1u);
            for (;;) {
                __syncthreads();
                if (tid == 0) *uq = nxt;
                __syncthreads();
                const int un = (int)*uq;
                if (un >= 1008 + 1024) break;
                if (tid == 0) nxt = atomicAdd(CTL + CW_ATTQ + rep, 1u);
                if (un < 1008) attn_unit(ws, lds, un & 15, un >> 4, false, tid, wave, lane);
                else attn_unit(ws, lds, (un - 1008) & 15, (un - 1008) >> 4, true, tid, wave, lane);
            }
        }
    }
    SEAM(5);
    if (IN(6)) REPS(6) { phase_p5_merge(ws, gw, NGW, lane);
        phase_p5_rwkv_wy(ws, PREV, GG, args.in[10], args.in[11], args.in[12], args.in[8], args.in[9], lds, gw, NGW, wave, lane); }
    SEAM(6);
    if (IN(7)) {
        pg8::Gemm g{(const bf16*)(ws + WS_YB), (const bf16*)(ws + WS_WBR), 512, 1024, 1024};
        MixOrder S{G, bx, RSH(7)};
        EpiMix E{(bf16*)(ws + WS_MIXED), (const bf16*)(ws + WS_SGA), (const bf16*)(ws + WS_SGR)};
        pg8::gemm_phase<EpiMix, MixOrder>(lds, g, S, E);
    }
    SEAM(7);
    if (IN(8)) {
        pg8::Gemm g{(const bf16*)(ws + WS_MIXED), (const bf16*)(ws + WS_WOUT), 1024, 1024, 1024};
        GridOrder S; S.init(T / 256, 4, G, bx, 0u, RSH(8));
        EpiOut E{OUT, x};
        pg8::gemm_phase<EpiOut, GridOrder>(lds, g, S, E);
    }
    SEAM(8);
    if (IN(9)) REPS(9) { __syncthreads(); phase_p8(OUT, args.in[16], args.in[17], args.in[18], args.in[19], ws, lds, (LAS unsigned*)(lds + MISC_OFF + 256), bx, G, tid, wave, lane, rep == 0); }
    SEAM(9);
    if (IN(10)) { phase_p9(args.in[20], args.in[22], ws, lds, (LAS unsigned*)(lds + MISC_OFF + 512), bx, G, gw, NGW, tid, wave, lane); }
    SEAM(10);
    if (IN(11)) {
        pg8::Gemm g{(const bf16*)(ws + WS_HB), (const bf16*)(ws + WS_W1T), 1024, 1024, 1024, (const int*)(ws + WS_ROWIDX)};
        MoeOrder S{G, bx, 8, (int)__builtin_nontemporal_load(CTL + CW_NTILES), (const int*)(ws + WS_TILEE), 2048u * 1024u * 2u, RSH(11)};
        EpiW1 E{(bf16*)(ws + WS_ACT), args.in[21]};
        pg8::gemm_phase<EpiW1, MoeOrder, true>(lds, g, S, E);
    }
    SEAM(11);
    if (IN(12)) {
        pg8::Gemm g{(const bf16*)(ws + WS_ACT), (const bf16*)(ws + WS_W2T), 1024, 1024, 1024};
        MoeOrder S{G, bx, 4, (int)__builtin_nontemporal_load(CTL + CW_NTILES), (const int*)(ws + WS_TILEE), 1024u * 1024u * 2u, RSH(12)};
        EpiW2 E{(bf16*)(ws + WS_YS), args.in[23], (const float*)(ws + WS_SLOTG)};
        pg8::gemm_phase<EpiW2, MoeOrder>(lds, g, S, E);
    }
    SEAM(12);
    if (IN(13)) REPS(13) { phase_final(OUT, (rep == RSH(13)) ? OUT : (float*)(ws + WS_PRE), args.in[16], args.in[17], args.in[24], args.in[25], ws, gw, NGW, lane); }
#undef IN
#undef SEAM
}

extern "C" void kernel_launch(void* const* d_in, const int* in_sizes, int n_in, void* d_out, int out_size, void* d_ws, size_t ws_size, hipStream_t stream) {
    static int grid = 0;
    if (grid == 0) {
        if (n_in != 26 || out_size != T * D || ws_size < WS_END) { fprintf(stderr, "kernel_launch: unexpected shapes (n_in %d, out %d, ws %zu < %zu)\n", n_in, out_size, ws_size, (size_t)WS_END); grid = -1; return; }
        int dev = 0, cus = 0, per_cu = 0;
        if (hipGetDevice(&dev) != hipSuccess || hipDeviceGetAttribute(&cus, hipDeviceAttributeMultiprocessorCount, dev) != hipSuccess) { grid = -1; return; }
        if (hipFuncSetAttribute((const void*)hybrid_fwd, hipFuncAttributeMaxDynamicSharedMemorySize, LDS_BYTES) != hipSuccess) { fprintf(stderr, "kernel_launch: hipFuncSetAttribute failed\n"); grid = -1; return; }
        if (hipOccupancyMaxActiveBlocksPerMultiprocessor(&per_cu, (const void*)hybrid_fwd, NTHR, LDS_BYTES) != hipSuccess || per_cu < 1) { fprintf(stderr, "kernel_launch: occupancy query says %d blocks/CU\n", per_cu); }
        (void)hipGetLastError();
        grid = cus;
    }
    if (grid < 0) return;
    if (hipMemsetAsync((char*)d_ws + WS_CTL, 0, ZERO_BYTES, stream) != hipSuccess) { fprintf(stderr, "kernel_launch: memset failed\n"); return; }
    Args a{};
    for (int i = 0; i < 26; ++i) a.in[i] = (const float*)d_in[i];
    a.out = (float*)d_out; a.ws = (unsigned char*)d_ws;
#if MK_PER_PHASE
    for (int p = 0; p < NPHASE; ++p) { a.ph_lo = p; a.ph_hi = p + 1; hipLaunchKernelGGL(hybrid_fwd, dim3(grid), dim3(NTHR), LDS_BYTES, stream, a); }
#else
    a.ph_lo = 0; a.ph_hi = NPHASE;
    hipLaunchKernelGGL(hybrid_fwd, dim3(grid), dim3(NTHR), LDS_BYTES, stream, a);
#endif
    const hipError_t le = hipPeekAtLastError();
    if (le != hipSuccess) fprintf(stderr, "kernel_launch: launch failed: %s\n", hipGetErrorName(le));
}
```

```cpp
#include <hip/hip_runtime.h>
#include <cstdio>
#include <cstdint>

#define GAS __attribute__((address_space(1)))
#define LAS __attribute__((address_space(3)))
#define CAS __attribute__((address_space(4)))
typedef unsigned short bf16;
typedef unsigned v4u __attribute__((ext_vector_type(4)));
typedef unsigned v2u __attribute__((ext_vector_type(2)));
typedef float f32x4 __attribute__((ext_vector_type(4)));
typedef float f32x2 __attribute__((ext_vector_type(2)));
typedef short bf16x8 __attribute__((ext_vector_type(8)));
typedef GAS unsigned gu32;
#define RLX_AGENT __ATOMIC_RELAXED, __HIP_MEMORY_SCOPE_AGENT
#define LDS_WAIT() asm volatile("s_waitcnt lgkmcnt(0)" ::: "memory")
#define VM_WAIT() asm volatile("s_waitcnt vmcnt(0)" ::: "memory")

#ifndef REPEAT_MASK
#define REPEAT_MASK 0
#endif
#define REPS(k) for (int rep = 0; rep < 1 + (((REPEAT_MASK) >> (k)) & 1); ++rep)
constexpr int NWAVES = 8, NTHR = 512;
constexpr int T = 32768, D = 1024, SEQ = 16384, NBLK = 64  ;
constexpr int IN_COLS = 5408, NPROJ = 5632  ;
constexpr int OFF_Q = 1824, OFF_AK = 2336, OFF_AV = 2848, OFF_GA = 3360, OFF_GR = 4384, RWC = 1824;
constexpr int NEXP = 32, FF = 1024, NSLOT_MAX = 4 * T + NEXP * 256  , NTILE_MAX = NSLOT_MAX / 256  ;
constexpr int RCH = 128  , NCH = SEQ / RCH  ;
constexpr float LN_EPS = 1e-5f, GN_EPS = 64e-5f, ALPHA = 1.189207115002721f, SW_ALPHA = 1.702f, SW_LIMIT = 7.0f;

constexpr size_t MiB = 1u << 20;
constexpr size_t WS_CTL = 0, ZERO_BYTES = 2 * MiB;
constexpr size_t WS_KMEAN = 1 * MiB;
constexpr size_t WS_ROWIDX = 1 * MiB + 256 * 1024;
constexpr size_t WS_ROPE = 2 * MiB;
constexpr size_t WS_WBR = 6 * MiB, WS_WOUT = 8 * MiB, WS_WLORA = 10 * MiB;
constexpr size_t WS_TILEE = 11 * MiB;
constexpr size_t WS_SEL = 12 * MiB;
constexpr size_t WS_STATS = 13 * MiB;
constexpr size_t WS_TOPE = WS_STATS + 256 * 1024, WS_TOPG = WS_TOPE + 512 * 1024, WS_TOKSLOT = WS_TOPG + 512 * 1024, WS_SLOTG = WS_TOKSLOT + 512 * 1024;
constexpr size_t WS_QR = 16 * MiB, WS_KR = 48 * MiB, WS_VR = 80 * MiB;
constexpr size_t WS_SGA = 112 * MiB, WS_SGR = 176 * MiB;
constexpr size_t WS_XB = 240 * MiB, WS_WIN = 304 * MiB;
constexpr size_t WS_APR = 872 * MiB;
constexpr size_t WS_YB = 240 * MiB;
constexpr size_t WS_RW = 320 * MiB;
constexpr size_t WS_MN = 320 * MiB, WS_HC = 384 * MiB, WS_PO = 416 * MiB, WS_PM = 544 * MiB, WS_PL = 548 * MiB;
constexpr size_t WS_PRE = 552 * MiB;
constexpr size_t WS_MIXED = 872 * MiB;
constexpr size_t WS_W1T = 16 * MiB, WS_W2T = 144 * MiB, WS_HB = 208 * MiB, WS_XG = 272 * MiB, WS_ACT = 544 * MiB, WS_YS = 272 * MiB;
constexpr size_t WS_END = 936 * MiB;
constexpr int CW_TMO = 0, CW_ATTQ = 64, CW_NTILES = 128, CW_ECNT = 192, CW_ECUR = 256, CW_BAR = 4096;

constexpr int RING_BYTES = 131072, MISC_OFF = 147456, LDS_BYTES = 154624;

__device__ __forceinline__ unsigned pk2(float lo, float hi) { unsigned r; asm("v_cvt_pk_bf16_f32 %0, %1, %2" : "=v"(r) : "v"(lo), "v"(hi)); return r; }
__device__ __forceinline__ unsigned f2bf(float f) { return pk2(f, f) & 0xffffu; }
__device__ __forceinline__ float bf2f(unsigned b) { return __builtin_bit_cast(float, b << 16); }
__device__ __forceinline__ float bflo(unsigned w) { return __builtin_bit_cast(float, w << 16); }
__device__ __forceinline__ float bfhi(unsigned w) { return __builtin_bit_cast(float, w & 0xffff0000u); }
__device__ __forceinline__ float wave_sum(float v) {
#pragma unroll
    for (int o = 1; o < 64; o <<= 1) v += __shfl_xor(v, o);
    return v;
}
__device__ __forceinline__ unsigned lds_add(LAS unsigned* p, unsigned v) { return __hip_atomic_fetch_add(p, v, __ATOMIC_RELAXED, __HIP_MEMORY_SCOPE_WORKGROUP); }
__device__ __forceinline__ float sigmoidf_(float x) { return 1.0f / (1.0f + __expf(-x)); }

namespace pg8 {
constexpr int BM = 256, BK = 64, HALF = 128, HTB = HALF * BK * 2, STAGE_BYTES = 8 * HTB;
__host__ __device__ __forceinline__ int lds_byte(int r, int c) { const int st = (r >> 4) * 2 + (c >> 5), rr = r & 15, cc = c & 31, ob = rr * 64 + cc * 2; return st * 1024 + (ob ^ (((ob >> 9) & 1) << 5)); }
__host__ __device__ __forceinline__ void stage_rc(int b, int& R, int& C) { const int st = b / 1024, sb = b % 1024, swz = sb ^ (((sb >> 9) & 1) << 5); R = (st >> 1) * 16 + swz / 64; C = (st & 1) * 32 + (swz % 64) / 2; }
__host__ __device__ __forceinline__ int perm32(int rho) { const int n = rho >> 4, i = rho & 15; return 8 * (i >> 2) + 4 * n + (i & 3); }

struct Unit { int pm, pn; unsigned aoff, boff; int aux; };
struct Gemm { const bf16* A; const bf16* Bt; int K, lda, ldb; const int* rowidx; };

__device__ __forceinline__ unsigned cvt_pk_bf16(float lo, float hi) { unsigned r; asm volatile("v_cvt_pk_bf16_f32 %0, %1, %2" : "=v"(r) : "v"(lo), "v"(hi)); return r; }

#ifndef PG8_ALIGN_EPI
#define PG8_ALIGN_EPI 1
#endif
template <class Epi, class Sched, bool GATHER = false>
__device__ __forceinline__ void gemm_phase(LAS unsigned char* lds, const Gemm g, const Sched& S, const Epi& E) {
    const int tid = threadIdx.x, wid = __builtin_amdgcn_readfirstlane(tid >> 6), lane = tid & 63, wr = wid >> 2, wc = wid & 3, fr = lane & 15, fq = lane >> 4;
    int nt = g.K / BK; asm volatile("" : "+s"(nt));
    unsigned voffA[2], voffB[2];
#pragma unroll
    for (int i = 0; i < 2; ++i) { int R, C; stage_rc(tid * 16 + i * 8192, R, C); const int Rb = (R & ~31) + perm32(R & 31);
        voffA[i] = (unsigned)(R * g.lda + C) * 2u; voffB[i] = (unsigned)(Rb * g.ldb + C) * 2u; }
    const size_t kstep = (size_t)(BK * 2);
    unsigned gaC[2][2], gaN[2][2];
#define PG8_ROWS(ga, U) do { _Pragma("unroll") for (int _h = 0; _h < 2; ++_h) _Pragma("unroll") for (int _i = 0; _i < 2; ++_i) { int R, C; stage_rc(tid * 16 + _i * 8192, R, C); \
        ga[_h][_i] = (unsigned)g.rowidx[(U).pm * 256 + _h * 128 + R] * (unsigned)(g.lda * 2) + (unsigned)C * 2u; } } while (0)
#define PG8_STA(bufoff, nx, kb, h) do { if constexpr (GATHER) { unsigned _v[2]; _v[0] = (nx) ? gaN[h][0] : gaC[h][0]; _v[1] = (nx) ? gaN[h][1] : gaC[h][1]; PG8_STAGE(bufoff, (const char*)g.A + (kb), _v); } \
        else { PG8_STAGE(bufoff, ((nx) ? nA : cA) + (kb) + (h) * hstepA, voffA); } } while (0)
    const size_t hstepA = (size_t)HALF * g.lda * 2, hstepB = (size_t)HALF * g.ldb * 2;
    const size_t tstepA = 2 * hstepA, tstepB = 2 * hstepB;
    const unsigned ldsw = (unsigned)wid * 1024u;
    const int aoff = lds_byte(wr * 64 + fr, fq * 8), boff = lds_byte(wc * 32 + fr, fq * 8);
#define PG8_SA(b, h) (((b) * 2 + (h)) * HTB)
#define PG8_SB(b, h) ((4 + (b) * 2 + (h)) * HTB)
#define PG8_STAGE(bufoff, gbase, voff) do { _Pragma("unroll") for (int _i = 0; _i < 2; ++_i) \
        __builtin_amdgcn_global_load_lds((const unsigned*)((const char*)(gbase) + (voff)[_i]), (LAS unsigned*)(lds + (bufoff) + ldsw + _i * 8192), 16, 0, 0); } while (0)
#define PG8_LDA(dst, b, h) do { _Pragma("unroll") for (int m = 0; m < 4; ++m) _Pragma("unroll") for (int k = 0; k < 2; ++k) dst[m][k] = *(const LAS bf16x8*)(lds + PG8_SA(b, h) + aoff + m * 2048 + k * 1024); } while (0)
#define PG8_LDB(dst, b, h) do { _Pragma("unroll") for (int n = 0; n < 2; ++n) _Pragma("unroll") for (int k = 0; k < 2; ++k) dst[n][k] = *(const LAS bf16x8*)(lds + PG8_SB(b, h) + boff + n * 2048 + k * 1024); } while (0)
#define PG8_MMA(ai, bj, At, Bt) do { __builtin_amdgcn_s_setprio(1); _Pragma("unroll") for (int m = 0; m < 4; ++m) _Pragma("unroll") for (int n = 0; n < 2; ++n) _Pragma("unroll") for (int k = 0; k < 2; ++k) \
        acc[ai][bj][m][n] = __builtin_amdgcn_mfma_f32_16x16x32_bf16(Bt[n][k], At[m][k], acc[ai][bj][m][n], 0, 0, 0); __builtin_amdgcn_s_setprio(0); } while (0)
#define PG8_WAIT_V(n) asm volatile("s_waitcnt vmcnt(" #n ")" ::: "memory")
#define PG8_WAIT_L(n) asm volatile("s_waitcnt lgkmcnt(" #n ")" ::: "memory")
#define PG8_BAR __builtin_amdgcn_s_barrier()
#define PG8_SCHED __builtin_amdgcn_sched_barrier(0)
    Unit cur, nxt; int ui = 0;
    if (!S.next(0, cur)) return;
    f32x4 acc[2][2][4][2];
#pragma unroll
    for (int a = 0; a < 2; ++a)
#pragma unroll
        for (int b = 0; b < 2; ++b)
#pragma unroll
            for (int m = 0; m < 4; ++m)
#pragma unroll
                for (int n = 0; n < 2; ++n) acc[a][b][m][n] = (f32x4){0.f, 0.f, 0.f, 0.f};
    bf16x8 At[4][2], B0[2][2], B1[2][2];
    const char* cA = (const char*)g.A + (size_t)cur.pm * tstepA + cur.aoff; const char* cB = (const char*)g.Bt + (size_t)cur.pn * tstepB + cur.boff;
    const char* nA = cA;
    if constexpr (GATHER) PG8_ROWS(gaC, cur);
    PG8_STAGE(PG8_SB(0, 0), cB, voffB); PG8_STAGE(PG8_SB(0, 1), cB + hstepB, voffB); PG8_STA(PG8_SA(0, 0), false, 0, 0); PG8_STA(PG8_SA(0, 1), false, 0, 1);
    if (wr == 1) PG8_BAR;
    PG8_WAIT_V(2); PG8_BAR;
    PG8_STAGE(PG8_SB(1, 0), cB + kstep, voffB); PG8_STA(PG8_SA(1, 0), false, kstep, 0); PG8_STAGE(PG8_SB(1, 1), cB + hstepB + kstep, voffB);
    PG8_WAIT_V(6); PG8_BAR;
    for (;;) {
        const bool has_next = S.next(ui + 1, nxt);
        nA = has_next ? (const char*)g.A + (size_t)nxt.pm * tstepA + nxt.aoff : cA;
        if constexpr (GATHER) { if (has_next) PG8_ROWS(gaN, nxt); else { _Pragma("unroll") for (int _h = 0; _h < 2; ++_h) { gaN[_h][0] = gaC[_h][0]; gaN[_h][1] = gaC[_h][1]; } } }
        const char* nB = has_next ? (const char*)g.Bt + (size_t)nxt.pn * tstepB + nxt.boff : cB;
        for (int t = 0; t < nt; t += 2) {
            const bool last = (t == nt - 2);
            const size_t k1 = (size_t)(t + 1) * kstep, k2 = last ? 0 : (size_t)(t + 2) * kstep, k3 = k2 + kstep;
            const char* b2 = last ? nB : cB + (size_t)(t + 2) * kstep; const char* b3 = b2 + kstep;
            PG8_LDB(B0, 0, 0); PG8_LDB(B1, 0, 1); PG8_SCHED; PG8_LDA(At, 0, 0); PG8_STA(PG8_SA(1, 1), false, k1, 1);
            PG8_WAIT_V(8); PG8_WAIT_L(0); PG8_BAR; PG8_MMA(0, 0, At, B0); PG8_MMA(0, 1, At, B1); PG8_BAR; PG8_SCHED;
            PG8_LDA(At, 0, 1); PG8_STAGE(PG8_SB(0, 0), b2, voffB); PG8_STAGE(PG8_SB(0, 1), b2 + hstepB, voffB); PG8_STA(PG8_SA(0, 0), last, k2, 0);
            PG8_WAIT_V(8); PG8_WAIT_L(0); PG8_BAR; PG8_MMA(1, 0, At, B0); PG8_MMA(1, 1, At, B1); PG8_BAR; PG8_SCHED;
            PG8_LDB(B0, 1, 0); PG8_LDB(B1, 1, 1); PG8_SCHED; PG8_LDA(At, 1, 0); PG8_STA(PG8_SA(0, 1), last, k2, 1);
            PG8_WAIT_V(8); PG8_WAIT_L(0); PG8_BAR; PG8_MMA(0, 0, At, B0); PG8_MMA(0, 1, At, B1); PG8_BAR; PG8_SCHED;
            PG8_LDA(At, 1, 1); PG8_STAGE(PG8_SB(1, 0), b3, voffB); PG8_STAGE(PG8_SB(1, 1), b3 + hstepB, voffB); PG8_STA(PG8_SA(1, 0), last, k3, 0);
            PG8_WAIT_V(8); PG8_WAIT_L(0); PG8_BAR; PG8_MMA(1, 0, At, B0); PG8_MMA(1, 1, At, B1); PG8_BAR; PG8_SCHED;
        }
        if (PG8_ALIGN_EPI && wr == 0) PG8_BAR;
        E(acc, cur, wr, wc, fr, fq);
        if (!has_next) break;
#pragma unroll
        for (int a = 0; a < 2; ++a)
#pragma unroll
            for (int b = 0; b < 2; ++b)
#pragma unroll
                for (int m = 0; m < 4; ++m)
#pragma unroll
                    for (int n = 0; n < 2; ++n) acc[a][b][m][n] = (f32x4){0.f, 0.f, 0.f, 0.f};
        cur = nxt; cA = nA; cB = nB; ++ui;
        if constexpr (GATHER) { _Pragma("unroll") for (int _h = 0; _h < 2; ++_h) { gaC[_h][0] = gaN[_h][0]; gaC[_h][1] = gaN[_h][1]; } }
        if (PG8_ALIGN_EPI && wr == 1) PG8_BAR;
    }
    PG8_WAIT_V(0);
    if (!PG8_ALIGN_EPI && wr == 0) PG8_BAR;
    PG8_BAR;
#undef PG8_SA
#undef PG8_ROWS
#undef PG8_STA
#undef PG8_SB
#undef PG8_STAGE
#undef PG8_LDA
#undef PG8_LDB
#undef PG8_MMA
#undef PG8_WAIT_V
#undef PG8_WAIT_L
#undef PG8_BAR
#undef PG8_SCHED
}
}

#define XB_TMO      128
#define XB_XCNT(j)  (256  + 64 * (j))
#define XB_XSUB(j)  (1280 + 64 * (j))
#define XB_XGEN(j)  (2304 + 64 * (j))
#define XB_TOP      3328
#define XB_TOPGEN   3392
#define XCD_BAR_WORDS 3456
#define XB_SPIN_CAP (1u << 22)

__device__ __forceinline__ unsigned xb_ld(unsigned* p)              { return __hip_atomic_load(p, __ATOMIC_RELAXED, __HIP_MEMORY_SCOPE_AGENT); }
__device__ __forceinline__ unsigned xb_add(unsigned* p, unsigned v) { return __hip_atomic_fetch_add(p, v, __ATOMIC_RELAXED, __HIP_MEMORY_SCOPE_AGENT); }
__device__ __forceinline__ unsigned xb_xcc_id() { return (unsigned)__builtin_amdgcn_s_getreg((3 << 11) | 20) & 0xFu; }
#define XB_SPIN(cond, bar) do { unsigned _sp = 0; while (cond) { __builtin_amdgcn_s_sleep(1); \
    if ((++_sp & 255u) == 0u) { if (xb_ld(&(bar)[XB_TMO])) break; if (_sp > XB_SPIN_CAP) { atomicAdd(&(bar)[XB_TMO], 1u); break; } } } } while (0)

struct XcdBarrier { unsigned* bar; unsigned x; volatile LAS unsigned* st; };

__device__ __forceinline__ XcdBarrier xcd_barrier_post(unsigned* bar, volatile LAS unsigned* st) {
    XcdBarrier b; b.bar = bar; b.x = xb_xcc_id(); b.st = st;
    if (threadIdx.x == 0) (void)xb_add(&bar[XB_XCNT(b.x)], 1u);
    return b;
}
__device__ __forceinline__ void xcd_barrier_complete(unsigned* bar, unsigned x, unsigned& nloc, unsigned& nx) {
    const unsigned G = gridDim.x * gridDim.y * gridDim.z;
    unsigned sum, cnt, mine, sp = 0u;
    for (;;) {
        sum = 0u; cnt = 0u; mine = 0u;
#pragma unroll
        for (unsigned j = 0; j < 16; ++j) { const unsigned c = xb_ld(&bar[XB_XCNT(j)]); sum += c; cnt += (c > 0u) ? 1u : 0u; mine = (j == x) ? c : mine; }
        if (sum == G) break;
        __builtin_amdgcn_s_sleep(1);
        if ((++sp & 255u) == 0u) { if (xb_ld(&bar[XB_TMO])) break; if (sp > XB_SPIN_CAP) { atomicAdd(&bar[XB_TMO], 1u); break; } }
    }
    nloc = mine > 0u ? mine : 1u; nx = cnt > 0u ? cnt : 1u;
}
__device__ __forceinline__ void xcd_barrier(const XcdBarrier& b) {
    asm volatile("s_waitcnt vmcnt(0)" ::: "memory");
    __syncthreads();
    if (threadIdx.x == 0) {
        unsigned* bar = b.bar;
        __builtin_amdgcn_s_waitcnt(0);
        unsigned nloc = b.st[0], nx = b.st[1];
        if (nloc == 0u) { xcd_barrier_complete(bar, b.x, nloc, nx); b.st[0] = nloc; b.st[1] = nx; }
        const unsigned old = xb_add(&bar[XB_XSUB(b.x)], 1u);
        const unsigned gen = old / nloc;
        if (old + 1u == (gen + 1u) * nloc) {
            __builtin_amdgcn_fence(__ATOMIC_RELEASE, "agent");
            asm volatile("s_waitcnt vmcnt(0)" ::: "memory");
            const unsigned og = xb_add(&bar[XB_TOP], 1u);
            const unsigned tg = og / nx;
            if (og + 1u == (tg + 1u) * nx) xb_add(&bar[XB_TOPGEN], 1u);
            else XB_SPIN(xb_ld(&bar[XB_TOPGEN]) == tg, bar);
            __builtin_amdgcn_fence(__ATOMIC_ACQUIRE, "agent");
            xb_add(&bar[XB_XGEN(b.x)], 1u);
            asm volatile("s_waitcnt vmcnt(0)" ::: "memory");
        } else {
            XB_SPIN(xb_ld(&bar[XB_XGEN(b.x)]) == gen, bar);
            __builtin_amdgcn_fence(__ATOMIC_ACQUIRE, "agent");
            asm volatile("s_waitcnt vmcnt(0)" ::: "memory");
        }
    }
    __syncthreads();
}

__device__ __forceinline__ int proj_srccol(int n) {
    if (n < 1024) { const int base = (n < 512) ? OFF_Q : OFF_AK; const int m = n & 511, h = m >> 6, p = m & 63; return base + h * 64 + (p >> 1) + 32 * (p & 1); }
    if (n < 1536) return OFF_AV + (n - 1024);
    if (n < 2560) return OFF_GA + (n - 1536);
    if (n < 3584) return OFF_GR + (n - 2560);
    if (n < 3584 + RWC) return n - 3584;
    return -1;
}
template <bool MAP>
__device__ __forceinline__ void transpose_item(const float* W, int N, bf16* WT, int ldk, int k0, int n0, int kdst0, LAS float* scr, int lane) {
    const int nl = lane & 31;
    int col = n0 + nl; if (MAP) col = proj_srccol(col);
    float tv[32];
#pragma unroll
    for (int i = 0; i < 32; ++i) { const int kk = 2 * i + (lane >> 5); tv[i] = (col >= 0) ? __builtin_nontemporal_load(W + (size_t)(k0 + kk) * N + col) : 0.f; }
#pragma unroll
    for (int i = 0; i < 32; ++i) { const int kk = 2 * i + (lane >> 5); scr[kk * 33 + nl] = tv[i]; }
    LDS_WAIT(); asm volatile("" ::: "memory");
    const int c = lane & 7;
#pragma unroll
    for (int j = 0; j < 4; ++j) { const int n = (lane >> 3) + 8 * j; const LAS float* s = scr + (8 * c) * 33 + n;
        v4u o; o.x = pk2(s[0 * 33], s[1 * 33]); o.y = pk2(s[2 * 33], s[3 * 33]); o.z = pk2(s[4 * 33], s[5 * 33]); o.w = pk2(s[6 * 33], s[7 * 33]);
        *(GAS v4u*)(WT + (size_t)(n0 + n) * ldk + kdst0 + k0 + 8 * c) = o; }
    LDS_WAIT(); asm volatile("" ::: "memory");
}

struct GridOrder {
    int nM, nN, nwg, G, c, rsh; unsigned asec;
    __device__ __forceinline__ void init(int nM_, int nN_, int G_, int c_, unsigned asec_, int rsh_) { nM = nM_; nN = nN_; nwg = nM * nN; G = G_; c = c_; asec = asec_; rsh = rsh_; }
    __device__ __forceinline__ bool next(int i, pg8::Unit& u) const {
        const long L = (long)(i >> rsh) * G + c; if (L >= nwg) return false;
        int wgid = (int)L; { const int q = nwg / 8, r = nwg % 8, xcd = wgid % 8, off = wgid / 8; wgid = (xcd < r ? xcd * (q + 1) : r * (q + 1) + (xcd - r) * q) + off; }
#ifndef GO_WGM
#define GO_WGM 4
#endif
        const int nig = GO_WGM * nN, gid = wgid / nig, fm = gid * GO_WGM, gsz = (nM - fm) < GO_WGM ? (nM - fm) : GO_WGM;
        u.pm = fm + ((wgid % nig) % gsz); u.pn = (wgid % nig) / gsz; u.aoff = asec * (unsigned)(u.pn >> 1); u.boff = 0u; u.aux = 0; return true;
    }
};
struct MixOrder {
    int G, c, rsh;
    __device__ __forceinline__ bool next(int i, pg8::Unit& u) const {
        int tl; if (G == 256) tl = (c & 7) * 64 + (i >> (1 + rsh)) * 32 + (c >> 3); else tl = (i >> (1 + rsh)) * G + c;
        if (tl >= 512 || (G == 256 && (i >> (1 + rsh)) >= 2)) return false;
        u.pm = tl >> 2; u.pn = tl & 3; u.aux = i & 1; u.aoff = u.boff = (unsigned)(i & 1) * 1024u; return true;
    }
};
struct MoeOrder {
    int G, c, nN, ntiles; const int* tile_e; unsigned estride; int rsh;
    __device__ __forceinline__ bool next(int i, pg8::Unit& u) const {
        const int U = ntiles * nN; int L;
        if ((G & 7) == 0) { const int perX = (U + 7) >> 3, cpx = G >> 3, li = (i >> rsh) * cpx + (c >> 3); if (li >= perX) return false; L = (c & 7) * perX + li; if (L >= U) return false; }
        else { L = (i >> rsh) * G + c; if (L >= U) return false; }
#ifndef MOE_WGM
#define MOE_WGM 4
#endif
        { const int gsz0 = MOE_WGM * nN, gi = L / gsz0, fm = gi * MOE_WGM, rem = ntiles - fm, gr = rem < MOE_WGM ? rem : MOE_WGM, uu = L - gi * gsz0; u.pm = fm + uu % gr; u.pn = uu / gr; }
        const int e = __builtin_nontemporal_load(tile_e + u.pm); u.aux = e; u.aoff = 0u; u.boff = (unsigned)e * estride; return true;
    }
};

#define EPI_ARGS const f32x4 (&acc)[2][2][4][2], const pg8::Unit& u, int wr, int wc, int fr, int fq
__device__ __forceinline__ v4u pack8(const f32x4 a, const f32x4 b) { v4u w; w.x = pg8::cvt_pk_bf16(a[0], a[1]); w.y = pg8::cvt_pk_bf16(a[2], a[3]); w.z = pg8::cvt_pk_bf16(b[0], b[1]); w.w = pg8::cvt_pk_bf16(b[2], b[3]); return w; }

struct EpiProj {
    bf16 *QR, *KR, *VR, *SGA, *SGR; float *KMEAN; const float* ROPE;
    float *PRE, *PREV, *RAW0, *RAW63; bf16* APR; const float* mu_shift;
    __device__ __forceinline__ void operator()(EPI_ARGS) const {
        const int pn = u.pn, row0 = u.pm * 256 + wr * 64 + fr, bb = u.pm >> 6;
        if (pn < 4) {
            const bool isk = pn >= 2;
            float ks[2][8];
#pragma unroll
            for (int bj = 0; bj < 2; ++bj)
#pragma unroll
                for (int e = 0; e < 8; ++e) ks[bj][e] = 0.f;
#pragma unroll
            for (int ai2 = 0; ai2 < 4; ++ai2) { const int ai = ai2 >> 1, mb = (ai2 & 1) * 2;
                f32x4 cq[4][2], sq[4][2];
#pragma unroll
                for (int m = mb; m < mb + 2; ++m)
#pragma unroll
                    for (int bj = 0; bj < 2; ++bj) { const int s_ = (row0 + ai * 128 + m * 16) & (SEQ - 1), i0 = ((bj * 128 + wc * 32 + 8 * fq) & 63) >> 1;
                        cq[m][bj] = *(const f32x4*)(ROPE + (size_t)s_ * 32 + i0); sq[m][bj] = *(const f32x4*)(ROPE + (size_t)SEQ * 32 + (size_t)s_ * 32 + i0); }
#pragma unroll
                for (int m = mb; m < mb + 2; ++m) {
                    const int t = row0 + ai * 128 + m * 16, s_ = t & (SEQ - 1);
#pragma unroll
                    for (int bj = 0; bj < 2; ++bj) {
                        const int cs = (pn & 1) * 256 + bj * 128 + wc * 32 + 8 * fq, h = cs >> 6, p0 = cs & 63;
                        const f32x4 c4 = cq[m][bj], s4 = sq[m][bj];
                        const f32x4 v0 = acc[ai][bj][m][0], v1 = acc[ai][bj][m][1];
                        f32x4 o0, o1;
                        o0[0] = v0[0] * c4[0] - v0[1] * s4[0]; o0[1] = v0[1] * c4[0] + v0[0] * s4[0];
                        o0[2] = v0[2] * c4[1] - v0[3] * s4[1]; o0[3] = v0[3] * c4[1] + v0[2] * s4[1];
                        o1[0] = v1[0] * c4[2] - v1[1] * s4[2]; o1[1] = v1[1] * c4[2] + v1[0] * s4[2];
                        o1[2] = v1[2] * c4[3] - v1[3] * s4[3]; o1[3] = v1[3] * c4[3] + v1[2] * s4[3];
                        bf16* dst = (isk ? KR : QR) + (((size_t)(bb * 8 + h) * SEQ + s_) * 64 + p0);
                        if (isk) {
#pragma unroll
                            for (int e = 0; e < 4; ++e) { ks[bj][e] += o0[e]; ks[bj][4 + e] += o1[e]; }
                        } else { o0 = o0 * 0.125f; o1 = o1 * 0.125f; }
                        *(v4u*)dst = pack8(o0, o1);
                    }
                }
                asm volatile("" ::: "memory");
            }
            if (isk) {
#pragma unroll
                for (int bj = 0; bj < 2; ++bj)
#pragma unroll
                    for (int e = 0; e < 8; ++e) { float v = ks[bj][e]; v += __shfl_xor(v, 1); v += __shfl_xor(v, 2); v += __shfl_xor(v, 4); v += __shfl_xor(v, 8); ks[bj][e] = v; }
                if (fr == 0) {
#pragma unroll
                    for (int bj = 0; bj < 2; ++bj) {
                        const int cs = (pn & 1) * 256 + bj * 128 + wc * 32 + 8 * fq, h = cs >> 6, p0 = cs & 63;
                        float* km = KMEAN + ((size_t)((bb * 8 + h) * NBLK + (u.pm & 63)) * 64 + p0);
#pragma unroll
                        for (int e = 0; e < 8; ++e) atomicAdd(km + e, ks[bj][e]);
                    }
                }
            }
        } else if (pn < 6) {
#pragma unroll
            for (int ai = 0; ai < 2; ++ai)
#pragma unroll
                for (int m = 0; m < 4; ++m) {
                    const int t = row0 + ai * 128 + m * 16, s = t & (SEQ - 1);
#pragma unroll
                    for (int bj = 0; bj < 2; ++bj) {
                        const int cs = (pn & 1) * 256 + bj * 128 + wc * 32 + 8 * fq, h = cs >> 6, p0 = cs & 63;
                        *(v4u*)(VR + (((size_t)(bb * 8 + h) * SEQ + s) * 64 + p0)) = pack8(acc[ai][bj][m][0], acc[ai][bj][m][1]);
                    }
                }
        } else if (pn < 14) {
            bf16* G = (pn < 10) ? SGA : SGR; const int cb = ((pn - 6) & 3) * 256;
#pragma unroll
            for (int ai = 0; ai < 2; ++ai)
#pragma unroll
                for (int m = 0; m < 4; ++m) {
                    const int t = row0 + ai * 128 + m * 16;
#pragma unroll
                    for (int bj = 0; bj < 2; ++bj) {
                        const int cs = cb + bj * 128 + wc * 32 + 8 * fq;
                        f32x4 a = acc[ai][bj][m][0], b = acc[ai][bj][m][1];
#pragma unroll
                        for (int e = 0; e < 4; ++e) { a[e] = sigmoidf_(a[e]); b[e] = sigmoidf_(b[e]); }
                        __builtin_nontemporal_store(pack8(a, b), (v4u*)(G + (size_t)t * 1024 + cs));
                    }
                }
        } else {
            const int seg = (pn - 14) >> 1;
            f32x4 mq[2][2];
#pragma unroll
            for (int bj = 0; bj < 2; ++bj) { const int r = (pn - 14) * 256 + bj * 128 + wc * 32 + 8 * fq;
                if (r < RWC) { mq[bj][0] = *(const f32x4*)(mu_shift + r); mq[bj][1] = *(const f32x4*)(mu_shift + r + 4); } else { mq[bj][0] = (f32x4){0.f, 0.f, 0.f, 0.f}; mq[bj][1] = mq[bj][0]; } }
#pragma unroll
            for (int ai = 0; ai < 2; ++ai)
#pragma unroll
                for (int m = 0; m < 4; ++m) {
                    const int t = row0 + ai * 128 + m * 16;
#pragma unroll
                    for (int bj = 0; bj < 2; ++bj) {
                        const int r = (pn - 14) * 256 + bj * 128 + wc * 32 + 8 * fq, rl = r & 511;
                        f32x4 c0 = acc[ai][bj][m][0], c1 = acc[ai][bj][m][1], p0, p1;
#pragma unroll
                        for (int e = 0; e < 4; ++e) {
                            float up0 = 0.f, up1 = 0.f; const float x0 = c0[e], x1 = c1[e];
                            asm volatile("s_nop 1\n\tv_mov_b32_dpp %0, %1 row_shr:1 row_mask:0xf bank_mask:0xf" : "+v"(up0) : "v"(x0));
                            asm volatile("s_nop 1\n\tv_mov_b32_dpp %0, %1 row_shr:1 row_mask:0xf bank_mask:0xf" : "+v"(up1) : "v"(x1));
                            if (m > 0) {
                                float cy0 = 0.f, cy1 = 0.f; const float y0 = acc[ai][bj][m > 0 ? m - 1 : 0][0][e], y1 = acc[ai][bj][m > 0 ? m - 1 : 0][1][e];
                                asm volatile("s_nop 1\n\tv_mov_b32_dpp %0, %1 row_newbcast:15 row_mask:0xf bank_mask:0xf" : "+v"(cy0) : "v"(y0));
                                asm volatile("s_nop 1\n\tv_mov_b32_dpp %0, %1 row_newbcast:15 row_mask:0xf bank_mask:0xf" : "+v"(cy1) : "v"(y1));
                                up0 = fr == 0 ? cy0 : up0; up1 = fr == 0 ? cy1 : up1;
                            }
                            p0[e] = up0; p1[e] = up1;
                        }
                        f32x4 s0 = c0 + (p0 - c0) * mq[bj][0], s1 = c1 + (p1 - c1) * mq[bj][1];
                        if (m == 0 && fr == 0) { s0 = c0; s1 = c1; float* d = RAW0 + (size_t)(t >> 6) * 2048 + r; *(f32x4*)d = c0; *(f32x4*)(d + 4) = c1; }
                        if (m == 3 && fr == 15) { float* d = RAW63 + (size_t)(t >> 6) * 2048 + r; *(f32x4*)d = c0; *(f32x4*)(d + 4) = c1; }
                        if (seg == 0) { float* d = PRE + ((size_t)t * 8 + (rl >> 6)) * 320 + 256 + (rl & 63); *(f32x4*)d = s0; *(f32x4*)(d + 4) = s1; }
                        else if (seg == 1) { float* d = PRE + ((size_t)t * 8 + (rl >> 6)) * 320 + 192 + (rl & 63); *(f32x4*)d = s0; *(f32x4*)(d + 4) = s1; }
                        else if (seg == 2) { float* d = PREV + (size_t)t * 512 + rl; *(f32x4*)d = s0; *(f32x4*)(d + 4) = s1; }
                        else {
                            const int kind = rl < 64 ? 0 : (rl < 128 ? 1 : 2);
#pragma unroll
                            for (int e = 0; e < 4; ++e) {
                                if (kind == 0) { s0[e] = 2.0f * sigmoidf_(2.0f * s0[e]) - 1.0f; s1[e] = 2.0f * sigmoidf_(2.0f * s1[e]) - 1.0f; }
                                else if (kind == 2) { s0[e] = sigmoidf_(s0[e]); s1[e] = sigmoidf_(s1[e]); } }
                            *(v4u*)(APR + (size_t)t * 512 + rl) = pack8(s0, s1);
                        }
                    }
                    asm volatile("" ::: "memory");
                }
        }
    }
};

struct EpiLora {
    float *PRE, *G; const float *w0, *a0;
    __device__ __forceinline__ void operator()(EPI_ARGS) const {
        const int sec = u.pn >> 1, row0 = u.pm * 256 + wr * 64 + fr, cb = (u.pn & 1) * 256 + wc * 32 + 8 * fq;
        if (sec < 2) {
            const float* cst = sec ? a0 : w0; f32x4 wq[2][2];
#pragma unroll
            for (int bj = 0; bj < 2; ++bj) { wq[bj][0] = *(const f32x4*)(cst + cb + bj * 128); wq[bj][1] = *(const f32x4*)(cst + cb + bj * 128 + 4); }
#pragma unroll
            for (int ai = 0; ai < 2; ++ai) {
#pragma unroll
                for (int m = 0; m < 4; ++m)
#pragma unroll
                    for (int bj = 0; bj < 2; ++bj) {
                        const int t = row0 + ai * 128 + m * 16, c = cb + bj * 128;
                        float* pre = PRE + ((size_t)t * 8 + (c >> 6)) * 320 + (c & 63) + (sec ? 128 : 64);
                        f32x4 o0, o1;
#pragma unroll
                        for (int e = 0; e < 4; ++e) {
                            const float z0 = sigmoidf_(wq[bj][0][e] + acc[ai][bj][m][0][e]), z1 = sigmoidf_(wq[bj][1][e] + acc[ai][bj][m][1][e]);
                            o0[e] = sec ? z0 : __expf(-0.6065306597126334f * z0); o1[e] = sec ? z1 : __expf(-0.6065306597126334f * z1); }
                        *(f32x4*)pre = o0; *(f32x4*)(pre + 4) = o1;
                    }
                asm volatile("" ::: "memory");
            }
        } else {
#pragma unroll
            for (int ai = 0; ai < 2; ++ai)
#pragma unroll
                for (int m = 0; m < 4; ++m)
#pragma unroll
                    for (int bj = 0; bj < 2; ++bj) {
                        const int t = row0 + ai * 128 + m * 16, c = cb + bj * 128;
                        float* d = G + (size_t)t * 512 + c; *(f32x4*)d = acc[ai][bj][m][0]; *(f32x4*)(d + 4) = acc[ai][bj][m][1];
                    }
        }
    }
};

struct EpiMix {
    bf16 *MIXED; const bf16 *SGA, *SGR;
    __device__ __forceinline__ void operator()(EPI_ARGS) const {
        const int row0 = u.pm * 256 + wr * 64 + fr; const bf16* SG = u.aux ? SGR : SGA;
        const size_t cofs = (size_t)u.pn * 256 + wc * 32 + 8 * fq;
#pragma unroll
        for (int ai = 0; ai < 2; ++ai) {
            v4u gq[4][2], pq[4][2];
#pragma unroll
            for (int m = 0; m < 4; ++m)
#pragma unroll
                for (int bj = 0; bj < 2; ++bj) { const size_t off = (size_t)(row0 + ai * 128 + m * 16) * 1024 + cofs + bj * 128; gq[m][bj] = __builtin_nontemporal_load((const v4u*)(SG + off)); if (u.aux) pq[m][bj] = *(const v4u*)(MIXED + off); }
#pragma unroll
            for (int m = 0; m < 4; ++m)
#pragma unroll
                for (int bj = 0; bj < 2; ++bj) {
                    const size_t off = (size_t)(row0 + ai * 128 + m * 16) * 1024 + cofs + bj * 128; const v4u g = gq[m][bj];
                    f32x4 a = acc[ai][bj][m][0], b = acc[ai][bj][m][1];
                    a[0] *= bflo(g.x); a[1] *= bfhi(g.x); a[2] *= bflo(g.y); a[3] *= bfhi(g.y); b[0] *= bflo(g.z); b[1] *= bfhi(g.z); b[2] *= bflo(g.w); b[3] *= bfhi(g.w);
                    if (u.aux) { const v4u p = pq[m][bj];
                        a[0] += bflo(p.x); a[1] += bfhi(p.x); a[2] += bflo(p.y); a[3] += bfhi(p.y); b[0] += bflo(p.z); b[1] += bfhi(p.z); b[2] += bflo(p.w); b[3] += bfhi(p.w); }
                    *(v4u*)(MIXED + off) = pack8(a, b);
                }
            asm volatile("" ::: "memory");
        }
    }
};

struct EpiOut {
    float* PRE1; const float* X;
    __device__ __forceinline__ void operator()(EPI_ARGS) const {
        const int row0 = u.pm * 256 + wr * 64 + fr; const size_t cofs = (size_t)u.pn * 256 + wc * 32 + 8 * fq;
#pragma unroll
        for (int ai = 0; ai < 2; ++ai) {
            f32x4 x0[4][2], x1[4][2];
#pragma unroll
            for (int m = 0; m < 4; ++m)
#pragma unroll
                for (int bj = 0; bj < 2; ++bj) { const size_t off = (size_t)(row0 + ai * 128 + m * 16) * 1024 + cofs + bj * 128; x0[m][bj] = __builtin_nontemporal_load((const f32x4*)(X + off)); x1[m][bj] = __builtin_nontemporal_load((const f32x4*)(X + off + 4)); }
#pragma unroll
            for (int m = 0; m < 4; ++m)
#pragma unroll
                for (int bj = 0; bj < 2; ++bj) { const size_t off = (size_t)(row0 + ai * 128 + m * 16) * 1024 + cofs + bj * 128;
                    *(f32x4*)(PRE1 + off) = x0[m][bj] * ALPHA + acc[ai][bj][m][0]; *(f32x4*)(PRE1 + off + 4) = x1[m][bj] * ALPHA + acc[ai][bj][m][1]; }
            asm volatile("" ::: "memory");
        }
    }
};

struct EpiW1 {
    bf16* ACT; const float* b1;
    __device__ __forceinline__ void operator()(EPI_ARGS) const {
        const int row0 = u.pm * 256 + wr * 64 + fr; const float* be = b1 + (size_t)u.aux * 2048 + u.pn * 256 + wc * 32 + 8 * fq;
        f32x4 bv[2][2];
#pragma unroll
        for (int bj = 0; bj < 2; ++bj) { bv[bj][0] = *(const f32x4*)(be + bj * 128); bv[bj][1] = *(const f32x4*)(be + bj * 128 + 4); }
#pragma unroll
        for (int ai = 0; ai < 2; ++ai) {
#pragma unroll
            for (int m = 0; m < 4; ++m) {
                const int r = row0 + ai * 128 + m * 16;
#pragma unroll
                for (int bj = 0; bj < 2; ++bj) {
                    const int c = u.pn * 256 + bj * 128 + wc * 32 + 8 * fq;
                    const f32x4 h0 = acc[ai][bj][m][0] + bv[bj][0], h1 = acc[ai][bj][m][1] + bv[bj][1];
                    float o[4];
#pragma unroll
                    for (int e = 0; e < 4; ++e) { const float gl = fminf(e < 2 ? h0[2 * e] : h1[2 * e - 4], SW_LIMIT); float ln = e < 2 ? h0[2 * e + 1] : h1[2 * e - 3]; ln = fminf(fmaxf(ln, -SW_LIMIT), SW_LIMIT);
                        o[e] = gl * sigmoidf_(SW_ALPHA * gl) * (ln + 1.0f); }
                    v2u w; w.x = pg8::cvt_pk_bf16(o[0], o[1]); w.y = pg8::cvt_pk_bf16(o[2], o[3]);
                    *(v2u*)(ACT + (size_t)r * 1024 + (c >> 1)) = w;
                }
            }
            asm volatile("" ::: "memory");
        }
    }
};

struct EpiW2 {
    bf16* YS; const float* b2; const float* SLOTG;
    __device__ __forceinline__ void operator()(EPI_ARGS) const {
        const int row0 = u.pm * 256 + wr * 64 + fr; const float* be = b2 + (size_t)u.aux * 1024 + u.pn * 256 + wc * 32 + 8 * fq;
        f32x4 bv[2][2]; float gt[2][4];
#pragma unroll
        for (int bj = 0; bj < 2; ++bj) { bv[bj][0] = *(const f32x4*)(be + bj * 128); bv[bj][1] = *(const f32x4*)(be + bj * 128 + 4); }
#pragma unroll
        for (int ai = 0; ai < 2; ++ai)
#pragma unroll
            for (int m = 0; m < 4; ++m) gt[ai][m] = SLOTG[row0 + ai * 128 + m * 16];
#pragma unroll
        for (int ai = 0; ai < 2; ++ai) {
#pragma unroll
            for (int m = 0; m < 4; ++m) {
                const int r = row0 + ai * 128 + m * 16;
#pragma unroll
                for (int bj = 0; bj < 2; ++bj) {
                    const int c = u.pn * 256 + bj * 128 + wc * 32 + 8 * fq;
                    const f32x4 y0 = (acc[ai][bj][m][0] + bv[bj][0]) * gt[ai][m], y1 = (acc[ai][bj][m][1] + bv[bj][1]) * gt[ai][m];
                    *(v4u*)(YS + (size_t)r * 1024 + c) = pack8(y0, y1);
                }
            }
            asm volatile("" ::: "memory");
        }
    }
};

__device__ __forceinline__ void phase_p0(const float* x, const float* w_in, const float* w_abr, const float* w_rbr, const float* w_out,
                                         const float* w_du, const float* w_au, const float* w_gu, unsigned char* ws, LAS unsigned char* lds, int gw, int NGW, int wave, int lane) {
    LAS float* scr = (LAS float*)(lds + wave * 16384);
    bf16* WIN = (bf16*)(ws + WS_WIN); bf16* WBR = (bf16*)(ws + WS_WBR); bf16* WOUT = (bf16*)(ws + WS_WOUT); bf16* WLORA = (bf16*)(ws + WS_WLORA);
    constexpr int I_IN = 16 * (NPROJ / 32), I_BR = 8 * 32, I_OUT = 16 * 32;
    constexpr int NITEMS = I_IN + 2 * I_BR + I_OUT;
    for (int it = gw; it < NITEMS; it += NGW) {
        int r = it;
        if (r < I_IN) { const int nb = r % (NPROJ / 32), kb = r / (NPROJ / 32); transpose_item<true>(w_in, IN_COLS, WIN, 1024, 64 * kb, 32 * nb, 0, scr, lane); continue; } r -= I_IN;
        if (r < I_BR) { transpose_item<false>(w_abr, 1024, WBR, 1024, 64 * (r / 32), 32 * (r % 32), 0, scr, lane); continue; } r -= I_BR;
        if (r < I_BR) { transpose_item<false>(w_rbr, 1024, WBR, 1024, 64 * (r / 32), 32 * (r % 32), 512, scr, lane); continue; } r -= I_BR;
        transpose_item<false>(w_out, 1024, WOUT, 1024, 64 * (r / 32), 32 * (r % 32), 0, scr, lane);
    }
    const int gt = gw * 64 + lane, NGT = NGW * 64;
    for (int i = gt; i < 1536 * 256; i += NGT) { const int n = i >> 8, k = i & 255, sec = n >> 9, c = n & 511;
        float v = 0.f; if (sec == 0) { if (k < 64) v = w_du[k * 512 + c]; } else if (sec == 1) { if (k < 64) v = w_au[k * 512 + c]; } else { if (k < 160) v = w_gu[k * 512 + c]; }
        WLORA[i] = (bf16)f2bf(v); }
    float* ROPE = (float*)(ws + WS_ROPE);
    for (int i = gt; i < SEQ * 32; i += NGT) { const int s = i >> 5, f = i & 31; const double inv = pow(10000.0, -(double)f / 32.0), ang = (double)s * inv; double sn, cs; sincos(ang, &sn, &cs);
        ROPE[i] = (float)cs; ROPE[SEQ * 32 + i] = (float)sn; }
    bf16* XB = (bf16*)(ws + WS_XB);
    for (size_t i0 = gt; i0 < (size_t)T * 1024 / 8; i0 += (size_t)NGT * 4) {
        f32x4 a[4], b[4];
#pragma unroll
        for (int q = 0; q < 4; ++q) { const size_t i = i0 + (size_t)q * NGT; if (i < (size_t)T * 128) { a[q] = __builtin_nontemporal_load((const f32x4*)(x + i * 8)); b[q] = __builtin_nontemporal_load((const f32x4*)(x + i * 8 + 4)); } }
#pragma unroll
        for (int q = 0; q < 4; ++q) { const size_t i = i0 + (size_t)q * NGT; if (i < (size_t)T * 128) {
            v4u o; o.x = pk2(a[q][0], a[q][1]); o.y = pk2(a[q][2], a[q][3]); o.z = pk2(b[q][0], b[q][1]); o.w = pk2(b[q][2], b[q][3]); *(v4u*)(XB + i * 8) = o; } }
    }
}

__device__ __forceinline__ float tshift(float cur, float prev, float mu) { return cur + (prev - cur) * mu; }
__device__ __forceinline__ void phase_p2_fix(const float* mu_shift, unsigned char* ws, float* PREV, int gw, int NGW, int lane) {
    const float* RAW0 = (const float*)(ws + WS_RW); const float* RAW63 = RAW0 + (size_t)(T / 64) * 2048; float* PRE = (float*)(ws + WS_PRE); bf16* APR = (bf16*)(ws + WS_APR);
    const int gt = gw * 64 + lane, NGT = NGW * 64;
    for (int i0 = gt; i0 < (T / 64) * 2048; i0 += NGT * 8) {
        float cv[8], pv[8], mv[8];
#pragma unroll
        for (int q = 0; q < 8; ++q) { const int idx = i0 + q * NGT; const int ii = idx < (T / 64) * 2048 ? idx : i0; const int n = ii >> 11, c = ii & 2047;
            const bool hp = ((n * 64) & (SEQ - 1)) != 0;
            cv[q] = RAW0[ii]; pv[q] = RAW63[hp ? ii - 2048 : ii]; mv[q] = mu_shift[c < RWC ? c : 0]; }
#pragma unroll
        for (int q = 0; q < 8; ++q) { const int idx = i0 + q * NGT; if (idx < (T / 64) * 2048) {
            const int n = idx >> 11, c = idx & 2047, t = n * 64, rl = c & 511; const bool hp = (t & (SEQ - 1)) != 0;
            const float sh = tshift(cv[q], hp ? pv[q] : 0.f, c < RWC ? mv[q] : 0.f);
            if (c < 512) PRE[((size_t)t * 8 + (rl >> 6)) * 320 + 256 + (rl & 63)] = sh;
            else if (c < 1024) PRE[((size_t)t * 8 + (rl >> 6)) * 320 + 192 + (rl & 63)] = sh;
            else if (c < 1536) PREV[(size_t)t * 512 + rl] = sh;
            else { const float a = rl < 64 ? 2.0f * sigmoidf_(2.0f * sh) - 1.0f : (rl < 128 ? sh : sigmoidf_(sh)); APR[(size_t)t * 512 + rl] = (bf16)f2bf(a); } } }
    }
}
__device__ __forceinline__ void phase_p2_gate(unsigned char* ws, LAS unsigned char* lds, int gw, int NGW, int wave, int lane) {
    const bf16* QR = (const bf16*)(ws + WS_QR); const float* KMEAN = (const float*)(ws + WS_KMEAN); unsigned* SEL = (unsigned*)(ws + WS_SEL);
    LAS float* km = (LAS float*)(lds + wave * 16384);
    for (int it = gw; it < 4096; it += NGW) {
        const int q4 = it & 3, ib = (it >> 2) & 63, h = (it >> 8) & 7, b = it >> 11, i = b ? 63 - ib : ib;
        const float* kmg = KMEAN + (size_t)((b * 8 + h) * NBLK) * 64;
        for (int j0 = 0; j0 < i; j0 += 8) {
            float kv[8];
#pragma unroll
            for (int q = 0; q < 8; ++q) { const int jj = (j0 + q < i) ? j0 + q : i - 1; kv[q] = kmg[jj * 64 + lane]; }
#pragma unroll
            for (int q = 0; q < 8; ++q) if (j0 + q < i) km[(j0 + q) * 64 + lane] = kv[q] * (1.0f / 256.0f);
        }
        LDS_WAIT(); asm volatile("" ::: "memory");
        const int s = i * 256 + q4 * 64 + lane, t = b * SEQ + s;
        const bf16* qrow = QR + ((size_t)(b * 8 + h) * SEQ + s) * 64;
        float q[64];
#pragma unroll
        for (int c = 0; c < 8; ++c) { const v4u w = *(const v4u*)(qrow + c * 8);
            q[c * 8 + 0] = bflo(w.x); q[c * 8 + 1] = bfhi(w.x); q[c * 8 + 2] = bflo(w.y); q[c * 8 + 3] = bfhi(w.y); q[c * 8 + 4] = bflo(w.z); q[c * 8 + 5] = bfhi(w.z); q[c * 8 + 6] = bflo(w.w); q[c * 8 + 7] = bfhi(w.w); }
        float b0 = -__builtin_inff(), b1 = b0, b2 = b0; unsigned i0 = 255u, i1 = 255u, i2 = 255u;
        for (int j = 0; j < i; ++j) {
            const LAS f32x4* kj = (const LAS f32x4*)(km + j * 64);
            float d0 = 0.f, d1 = 0.f, d2 = 0.f, d3 = 0.f;
#pragma unroll
            for (int c = 0; c < 16; ++c) { const f32x4 kv = kj[c]; d0 += q[4 * c] * kv[0]; d1 += q[4 * c + 1] * kv[1]; d2 += q[4 * c + 2] * kv[2]; d3 += q[4 * c + 3] * kv[3]; }
            const float dot = (d0 + d1) + (d2 + d3);
            if (dot > b0) { b2 = b1; i2 = i1; b1 = b0; i1 = i0; b0 = dot; i0 = (unsigned)j; }
            else if (dot > b1) { b2 = b1; i2 = i1; b1 = dot; i1 = (unsigned)j; }
            else if (dot > b2) { b2 = dot; i2 = (unsigned)j; }
        }
        SEL[(size_t)t * 8 + h] = i0 | (i1 << 8) | (i2 << 16) | 0xFF000000u;
        LDS_WAIT(); asm volatile("" ::: "memory");
    }
}

template <int N, int MODE = 0> __device__ __forceinline__ void fmac_bc(float& acc, float src, float other) {
    if constexpr (MODE == 0) asm volatile("v_fmac_f32_dpp %0, %1, %2 row_newbcast:%3 row_mask:0xf bank_mask:0xf" : "+v"(acc) : "v"(src), "v"(other), "n"(N));
    else if constexpr (MODE == 1) asm volatile("v_fmac_f32_dpp %0, %1, %2 quad_perm:[%3,%3,%3,%3] row_mask:0xf bank_mask:0xf" : "+v"(acc) : "v"(src), "v"(other), "n"(N & 3));
    else asm volatile("v_fmac_f32_e32 %0, %1, %2" : "+v"(acc) : "v"(src), "v"(other));
}
template <int N, int MODE = 0> __device__ __forceinline__ void mul_bc(float& h, float src) {
    if constexpr (MODE == 0) asm volatile("v_mul_f32_dpp %0, %1, %0 row_newbcast:%2 row_mask:0xf bank_mask:0xf" : "+v"(h) : "v"(src), "n"(N));
    else if constexpr (MODE == 1) asm volatile("v_mul_f32_dpp %0, %1, %0 quad_perm:[%2,%2,%2,%2] row_mask:0xf bank_mask:0xf" : "+v"(h) : "v"(src), "n"(N & 3));
    else asm volatile("v_mul_f32_e32 %0, %1, %0" : "+v"(h) : "v"(src));
}

__device__ __forceinline__ void split8(const f32x4 a, const f32x4 b, bf16x8& hi, bf16x8& lo) {
    v4u h; h.x = pg8::cvt_pk_bf16(a[0], a[1]); h.y = pg8::cvt_pk_bf16(a[2], a[3]); h.z = pg8::cvt_pk_bf16(b[0], b[1]); h.w = pg8::cvt_pk_bf16(b[2], b[3]);
    v4u l; l.x = pg8::cvt_pk_bf16(a[0] - bflo(h.x), a[1] - bfhi(h.x)); l.y = pg8::cvt_pk_bf16(a[2] - bflo(h.y), a[3] - bfhi(h.y));
    l.z = pg8::cvt_pk_bf16(b[0] - bflo(h.z), b[1] - bfhi(h.z)); l.w = pg8::cvt_pk_bf16(b[2] - bflo(h.w), b[3] - bfhi(h.w));
    hi = __builtin_bit_cast(bf16x8, h); lo = __builtin_bit_cast(bf16x8, l);
}
__device__ __forceinline__ void phase_p4_chain(unsigned char* ws, LAS unsigned char* lds, int bh, int wave, int lane) {
    const float* MN = (const float*)(ws + WS_MN); float* HC = (float*)(ws + WS_HC);
    LAS float* Hs = (LAS float*)lds;
    const int rt = wave >> 1, c0 = 2 * (wave & 1), ql = lane & 15, g = lane >> 4;
    for (int i = threadIdx.x; i < 64 * 68; i += NTHR) Hs[i] = 0.f;
    const float* mbase = MN + ((size_t)(bh * NCH) * 2) * 4096;
    const float* mrow = mbase + (16 * rt + ql) * 64 + 8 * g;
    const float* nrow = mbase + 4096 + (16 * c0 + ql) * 64 + 16 * rt + 4 * g;
    {
        float* snap = HC + (size_t)(bh * NCH) * 4096;
        for (int i = threadIdx.x; i < 1024; i += NTHR) *(f32x4*)(snap + 4 * i) = (f32x4){0.f, 0.f, 0.f, 0.f};
    }
    __syncthreads();
    struct CSet { f32x4 m00, m01, m10, m11, n0, n1; };
#define CH_LOAD(S, c_) do { const size_t o = (size_t)(((c_) < NCH - 1) ? (c_) : (NCH - 2)) * 8192; \
        S.m00 = *(const f32x4*)(mrow + o); S.m01 = *(const f32x4*)(mrow + o + 4); S.m10 = *(const f32x4*)(mrow + o + 32); S.m11 = *(const f32x4*)(mrow + o + 36); \
        S.n0 = *(const f32x4*)(nrow + o); S.n1 = *(const f32x4*)(nrow + o + 1024); } while (0)
#define CH_STEP(S, c_) do { \
        bf16x8 ah[2], al[2]; split8(S.m00, S.m01, ah[0], al[0]); split8(S.m10, S.m11, ah[1], al[1]); \
        f32x4 acc[2] = {S.n0, S.n1}; \
        _Pragma("unroll") for (int ci = 0; ci < 2; ++ci) { const LAS float* hcol = Hs + (16 * (c0 + ci) + ql) * 68 + 8 * g; \
            _Pragma("unroll") for (int sI = 0; sI < 2; ++sI) { bf16x8 bh_, bl_; \
                split8(*(const LAS f32x4*)(hcol + 32 * sI), *(const LAS f32x4*)(hcol + 32 * sI + 4), bh_, bl_); \
                acc[ci] = __builtin_amdgcn_mfma_f32_16x16x32_bf16(ah[sI], bh_, acc[ci], 0, 0, 0); \
                acc[ci] = __builtin_amdgcn_mfma_f32_16x16x32_bf16(al[sI], bh_, acc[ci], 0, 0, 0); \
                acc[ci] = __builtin_amdgcn_mfma_f32_16x16x32_bf16(ah[sI], bl_, acc[ci], 0, 0, 0); } } \
        __syncthreads(); \
        float* snap = HC + (size_t)(bh * NCH + (c_) + 1) * 4096; \
        _Pragma("unroll") for (int ci = 0; ci < 2; ++ci) { const int col = 16 * (c0 + ci) + ql; \
            *(LAS f32x4*)(Hs + col * 68 + 16 * rt + 4 * g) = acc[ci]; *(f32x4*)(snap + col * 64 + 16 * rt + 4 * g) = acc[ci]; } \
        __syncthreads(); } while (0)
    CSet s0, s1, s2, s3, s4, s5;
    CH_LOAD(s0, 0); CH_LOAD(s1, 1); CH_LOAD(s2, 2); CH_LOAD(s3, 3); CH_LOAD(s4, 4);
    for (int c = 0; c < NCH - 1; c += 6) {
        CH_LOAD(s5, c + 5); CH_STEP(s0, c);
        if (c + 1 < NCH - 1) { CH_LOAD(s0, c + 6); CH_STEP(s1, c + 1); }
        if (c + 2 < NCH - 1) { CH_LOAD(s1, c + 7); CH_STEP(s2, c + 2); }
        if (c + 3 < NCH - 1) { CH_LOAD(s2, c + 8); CH_STEP(s3, c + 3); }
        if (c + 4 < NCH - 1) { CH_LOAD(s3, c + 9); CH_STEP(s4, c + 4); }
        if (c + 5 < NCH - 1) { CH_LOAD(s4, c + 10); CH_STEP(s5, c + 5); }
    }
#undef CH_LOAD
#undef CH_STEP
}

__device__ __forceinline__ void attn_unit(unsigned char* ws, LAS unsigned char* lds, int bh, int j, bool own, int tid, int wave, int lane) {
    const bf16* QR = (const bf16*)(ws + WS_QR); const bf16* KR = (const bf16*)(ws + WS_KR); const bf16* VR = (const bf16*)(ws + WS_VR);
    const unsigned* SEL = (const unsigned*)(ws + WS_SEL);
    bf16* PO = (bf16*)(ws + WS_PO); float* PM = (float*)(ws + WS_PM); float* PL = (float*)(ws + WS_PL);
    LAS unsigned char* KS = lds; LAS unsigned char* VS = lds + 32768;
    LAS unsigned short* LIST = (LAS unsigned short*)(lds + 65536); LAS unsigned* CNT = (LAS unsigned*)(lds + 65536 + 32768);
    const int b = bh >> 3, h = bh & 7;
    __syncthreads();
    if (tid == 0) *CNT = 0u;
    {
        const bf16* Kg = KR + ((size_t)bh * SEQ + j * 256) * 64; const bf16* Vg = VR + ((size_t)bh * SEQ + j * 256) * 64;
#pragma unroll
        for (int i = 0; i < 4; ++i) {
            const int q = tid + 512 * i, key = q >> 3, c = q & 7;
            const v4u kv = *(const v4u*)(Kg + key * 64 + c * 8);
            *(LAS v4u*)(KS + key * 128 + ((c ^ ((key >> 1) & 7)) << 4)) = kv;
            const v4u vv = *(const v4u*)(Vg + key * 64 + c * 8);
            const int pos = (key & ~31) + 8 * ((key >> 2) & 3) + 4 * ((key >> 4) & 1) + (key & 3), cc = pos >> 3, pw = (pos & 7) * 2;
            const unsigned wv[4] = {vv.x, vv.y, vv.z, vv.w};
#pragma unroll
            for (int e = 0; e < 8; ++e) { const int d = c * 8 + e; const unsigned short val = (unsigned short)((e & 1) ? (wv[e >> 1] >> 16) : (wv[e >> 1] & 0xffffu));
                *(LAS unsigned short*)(VS + d * 512 + ((cc ^ (d & 15)) << 4) + pw) = val; }
        }
    }
    __syncthreads();
    int cnt = 256;
    if (!own) {
        for (int tt = (j + 1) * 256; tt < SEQ; tt += 2048) {
            unsigned wq[4];
#pragma unroll
            for (int q = 0; q < 4; ++q) { const int tl = tt + 512 * q + tid; wq[q] = (tl < SEQ) ? SEL[(size_t)(b * SEQ + tl) * 8 + h] : 0xffffffffu; }
#pragma unroll
            for (int q = 0; q < 4; ++q) {
                const int tl = tt + 512 * q + tid; const unsigned w = wq[q];
                const int n = ((w & 0xffu) == (unsigned)j) ? 0 : (((w >> 8) & 0xffu) == (unsigned)j) ? 1 : (((w >> 16) & 0xffu) == (unsigned)j) ? 2 : -1;
                const unsigned long long mk = __ballot(n >= 0);
                const int np = __popcll(mk);
                unsigned base = 0u;
                if (lane == 0 && np) base = lds_add(CNT, (unsigned)np);
                base = __shfl(base, 0);
                if (n >= 0) { const int rk = __popcll(mk & ((1ull << lane) - 1ull)); LIST[base + rk] = (unsigned short)((tl << 2) | n); }
            }
        }
        __syncthreads();
        cnt = (int)*CNT;
    }
    const int nitems = (cnt + 15) >> 4, ql = lane & 15, g = lane >> 4;
#define ATT_ITEM(r_) (own ? ((r_) >= 2 ? -1 : ((r_) ? 15 - wave : wave)) : ((wave + 8 * (r_) < nitems) ? wave + 8 * (r_) : -1))
#define ATT_FETCH(it_, entry_, valid_, q0_, q1_) do { const int e_ = (it_) * 16 + ql; valid_ = e_ < cnt; \
        if (own) entry_ = (unsigned)(((j * 256 + e_) << 2) | 3); else entry_ = LIST[valid_ ? e_ : (it_) * 16]; \
        const bf16* qrow_ = QR + ((size_t)bh * SEQ + (int)(entry_ >> 2)) * 64; q0_ = *(const bf16x8*)(qrow_ + 8 * g); q1_ = *(const bf16x8*)(qrow_ + 32 + 8 * g); } while (0)
    int itn = ATT_ITEM(0); unsigned entn = 0u; bool validn = false; bf16x8 qn0 = {}, qn1 = {};
    if (itn >= 0) ATT_FETCH(itn, entn, validn, qn0, qn1);
    for (int r = 0; itn >= 0; ++r) {
        const int it = itn; const unsigned entry = entn; const bool valid = validn; const bf16x8 qf0 = qn0, qf1 = qn1;
        itn = ATT_ITEM(r + 1);
        if (itn >= 0) ATT_FETCH(itn, entn, validn, qn0, qn1);
        const int tl = (int)(entry >> 2), slot = (int)(entry & 3u);
        const int ntile = own ? it + 1 : 16;
        f32x4 sc[16];
#pragma unroll
        for (int n2 = 0; n2 < 16; ++n2) {
            if (n2 < ntile) {
                const int key = 16 * n2 + ql, sw = (key >> 1) & 7;
                const bf16x8 a0 = *(const LAS bf16x8*)(KS + key * 128 + ((g ^ sw) << 4)), a1 = *(const LAS bf16x8*)(KS + key * 128 + (((4 + g) ^ sw) << 4));
                f32x4 a = __builtin_amdgcn_mfma_f32_16x16x32_bf16(a0, qf0, (f32x4){0.f, 0.f, 0.f, 0.f}, 0, 0, 0);
                sc[n2] = __builtin_amdgcn_mfma_f32_16x16x32_bf16(a1, qf1, a, 0, 0, 0);
            } else sc[n2] = (f32x4){-__builtin_inff(), -__builtin_inff(), -__builtin_inff(), -__builtin_inff()};
        }
        if (own) {
#pragma unroll
            for (int n2 = 0; n2 < 16; ++n2) if (n2 == it) {
#pragma unroll
                for (int rg = 0; rg < 4; ++rg) if (4 * g + rg > ql) sc[n2][rg] = -__builtin_inff();
            }
        }
        float mx = -__builtin_inff();
#pragma unroll
        for (int n2 = 0; n2 < 16; ++n2) mx = fmaxf(mx, fmaxf(fmaxf(sc[n2][0], sc[n2][1]), fmaxf(sc[n2][2], sc[n2][3])));
        mx = fmaxf(mx, __shfl_xor(mx, 16)); mx = fmaxf(mx, __shfl_xor(mx, 32));
        float ls = 0.f;
#pragma unroll
        for (int n2 = 0; n2 < 16; ++n2) {
#pragma unroll
            for (int rg = 0; rg < 4; ++rg) { const float p = __expf(sc[n2][rg] - mx); sc[n2][rg] = p; ls += p; }
        }
        ls += __shfl_xor(ls, 16); ls += __shfl_xor(ls, 32);
        f32x4 o[4];
#pragma unroll
        for (int dt = 0; dt < 4; ++dt) o[dt] = (f32x4){0.f, 0.f, 0.f, 0.f};
#pragma unroll
        for (int s2 = 0; s2 < 8; ++s2) {
            if (2 * s2 < ntile) {
                v4u pw; pw.x = pg8::cvt_pk_bf16(sc[2 * s2][0], sc[2 * s2][1]); pw.y = pg8::cvt_pk_bf16(sc[2 * s2][2], sc[2 * s2][3]);
                pw.z = pg8::cvt_pk_bf16(sc[2 * s2 + 1][0], sc[2 * s2 + 1][1]); pw.w = pg8::cvt_pk_bf16(sc[2 * s2 + 1][2], sc[2 * s2 + 1][3]);
                const bf16x8 pf = __builtin_bit_cast(bf16x8, pw);
#pragma unroll
                for (int dt = 0; dt < 4; ++dt) { const int d = 16 * dt + ql;
                    const bf16x8 va = *(const LAS bf16x8*)(VS + d * 512 + (((4 * s2 + g) ^ (d & 15)) << 4));
                    o[dt] = __builtin_amdgcn_mfma_f32_16x16x32_bf16(va, pf, o[dt], 0, 0, 0); }
            }
        }
        if (valid) {
            const float inv = 1.0f / ls;
            const size_t pair = ((size_t)(b * SEQ + tl) * 8 + h) * 4 + slot;
#pragma unroll
            for (int dt = 0; dt < 4; ++dt) { v2u w; w.x = pg8::cvt_pk_bf16(o[dt][0] * inv, o[dt][1] * inv); w.y = pg8::cvt_pk_bf16(o[dt][2] * inv, o[dt][3] * inv);
                *(v2u*)(PO + pair * 64 + 16 * dt + 4 * g) = w; }
            if (g == 0) { PM[pair] = mx; PL[pair] = ls; }
        }
    }
}

__device__ __forceinline__ void phase_p5_merge(unsigned char* ws, int gw, int NGW, int lane) {
    const unsigned* SEL = (const unsigned*)(ws + WS_SEL); const bf16* PO = (const bf16*)(ws + WS_PO); const float* PM = (const float*)(ws + WS_PM); const float* PL = (const float*)(ws + WS_PL);
    bf16* YB = (bf16*)(ws + WS_YB);
    const int h = lane >> 3, part = lane & 7;
    for (int t0 = gw * 4; t0 < T; t0 += NGW * 4) {
        unsigned w[4]; float m0[4], m1[4], m2[4], m3[4], l0[4], l1[4], l2[4], l3[4]; bool v0[4], v1[4], v2[4];
#pragma unroll
        for (int q = 0; q < 4; ++q) { w[q] = SEL[(size_t)(t0 + q) * 8 + h]; v0[q] = (w[q] & 0xffu) != 255u; v1[q] = ((w[q] >> 8) & 0xffu) != 255u; v2[q] = ((w[q] >> 16) & 0xffu) != 255u;
        }
        const float NI = -__builtin_inff();
#pragma unroll
        for (int q = 0; q < 4; ++q) { const size_t pb = ((size_t)(t0 + q) * 8 + h) * 4;
            const f32x4 pm = *(const f32x4*)(PM + pb), pl = *(const f32x4*)(PL + pb);
            m0[q] = v0[q] ? pm[0] : NI; m1[q] = v1[q] ? pm[1] : NI; m2[q] = v2[q] ? pm[2] : NI; m3[q] = pm[3];
            l0[q] = v0[q] ? pl[0] : 0.f; l1[q] = v1[q] ? pl[1] : 0.f; l2[q] = v2[q] ? pl[2] : 0.f; l3[q] = pl[3]; }
        v4u p0[4], p1[4], p2[4], p3[4];
#pragma unroll
        for (int q = 0; q < 4; ++q) { const size_t pb = ((size_t)(t0 + q) * 8 + h) * 4; const v4u z = {0u, 0u, 0u, 0u};
            const v4u r0 = __builtin_nontemporal_load((const v4u*)(PO + (pb + 0) * 64 + part * 8)), r1 = __builtin_nontemporal_load((const v4u*)(PO + (pb + 1) * 64 + part * 8)), r2 = __builtin_nontemporal_load((const v4u*)(PO + (pb + 2) * 64 + part * 8));
            p0[q] = v0[q] ? r0 : z; p1[q] = v1[q] ? r1 : z; p2[q] = v2[q] ? r2 : z; p3[q] = __builtin_nontemporal_load((const v4u*)(PO + (pb + 3) * 64 + part * 8)); }
#pragma unroll
        for (int q = 0; q < 4; ++q) {
            const float ms = fmaxf(fmaxf(m0[q], m1[q]), fmaxf(m2[q], m3[q]));
            float a0 = v0[q] ? l0[q] * __expf(m0[q] - ms) : 0.f, a1 = v1[q] ? l1[q] * __expf(m1[q] - ms) : 0.f, a2 = v2[q] ? l2[q] * __expf(m2[q] - ms) : 0.f, a3 = l3[q] * __expf(m3[q] - ms);
            const float inv = 1.0f / (((a0 + a1) + a2) + a3); a0 *= inv; a1 *= inv; a2 *= inv; a3 *= inv;
            float acc[8];
#define MRG(e, f, c_) acc[e] = a0 * f(p0[q].c_) + a1 * f(p1[q].c_) + a2 * f(p2[q].c_) + a3 * f(p3[q].c_)
            MRG(0, bflo, x); MRG(1, bfhi, x); MRG(2, bflo, y); MRG(3, bfhi, y); MRG(4, bflo, z); MRG(5, bfhi, z); MRG(6, bflo, w); MRG(7, bfhi, w);
#undef MRG
            v4u o; o.x = pk2(acc[0], acc[1]); o.y = pk2(acc[2], acc[3]); o.z = pk2(acc[4], acc[5]); o.w = pk2(acc[6], acc[7]);
            *(v4u*)(YB + (size_t)(t0 + q) * 1024 + h * 64 + part * 8) = o;
        }
    }
}


constexpr int WY_WRB = 18432;
constexpr int WY_TA = 0, WY_TB = 2304, WY_TK = 4608, WY_TR = 6912;
constexpr int WY_CB = 9216, WY_CK = 11264, WY_VT = 13312;
constexpr int WY_PK = 15360, WY_PRB = 15872, WY_PRK = 16384;
constexpr int WY_GC = 16896, WY_BON = 17152;

__device__ __forceinline__ bf16x8 frag_lo(v2u lo) { v4u w; w.x = lo.x; w.y = lo.y; w.z = 0u; w.w = 0u; return __builtin_bit_cast(bf16x8, w); }
__device__ __forceinline__ bf16x8 frag_2(v2u a, v2u b) { v4u w; w.x = a.x; w.y = a.y; w.z = b.x; w.w = b.y; return __builtin_bit_cast(bf16x8, w); }
__device__ __forceinline__ v2u pack4(const f32x4 v) { v2u w; w.x = pg8::cvt_pk_bf16(v[0], v[1]); w.y = pg8::cvt_pk_bf16(v[2], v[3]); return w; }
#define WY_MFMA(a, b, c) __builtin_amdgcn_mfma_f32_16x16x32_bf16(a, b, c, 0, 0, 0)

template <bool WITHV, bool WITHY>
__device__ __forceinline__ void wy_prep(LAS unsigned char* wl, const float* PRE, const float* PREV, int t0, int h, int lane, float rk, float kkc, float kac) {
    asm volatile("" : "+v"(lane));
    float kkv[16], wv[16], bv[16], kpv[16], rv[16], vt[16];
    const float* pre0 = PRE + ((size_t)t0 * 8 + h) * 320; const float* pv0 = PREV + (size_t)t0 * 512 + h * 64;
    const unsigned ul = (unsigned)lane;
#pragma unroll
    for (int t = 0; t < 16; ++t) { kkv[t] = (pre0 + (t * 2560 + 192))[ul]; wv[t] = (pre0 + (t * 2560 + 64))[ul]; bv[t] = (pre0 + (t * 2560 + 128))[ul];
        if (WITHV) vt[t] = (pv0 + t * 512)[ul];
        if (WITHY) rv[t] = (pre0 + (t * 2560 + 256))[ul]; }
    {
        float n2[16], q8[8], q4[4], q2[2], q1;
#pragma unroll
        for (int t = 0; t < 16; ++t) { const float x = kkv[t] * kkc; n2[t] = x * x; }
        { const bool hi = (lane & 32) != 0;
#pragma unroll
          for (int i = 0; i < 8; ++i) { const float keep = hi ? n2[i + 8] : n2[i], send = hi ? n2[i] : n2[i + 8]; q8[i] = keep + __shfl_xor(send, 32); } }
        { const bool hi = (lane & 16) != 0;
#pragma unroll
          for (int i = 0; i < 4; ++i) { const float keep = hi ? q8[i + 4] : q8[i], send = hi ? q8[i] : q8[i + 4]; q4[i] = keep + __shfl_xor(send, 16); } }
        { const bool hi = (lane & 8) != 0;
#pragma unroll
          for (int i = 0; i < 2; ++i) { const float keep = hi ? q4[i + 2] : q4[i], send = hi ? q4[i] : q4[i + 2]; q2[i] = keep + __shfl_xor(send, 8); } }
        { const bool hi = (lane & 4) != 0; const float keep = hi ? q2[1] : q2[0], send = hi ? q2[0] : q2[1]; q1 = keep + __shfl_xor(send, 4); }
        q1 += __shfl_xor(q1, 2); q1 += __shfl_xor(q1, 1);
#pragma unroll
        for (int t = 0; t < 16; ++t) {
            const float nn = __builtin_bit_cast(float, __builtin_amdgcn_readlane(__builtin_bit_cast(int, q1), ((t >> 3) & 1) * 32 + ((t >> 2) & 1) * 16 + ((t >> 1) & 1) * 8 + (t & 1) * 4));
            const float k = kkv[t], a = bv[t];
            const float kk = (k * kkc) / fmaxf(sqrtf(nn), 1e-12f);
            kkv[t] = kk; bv[t] = kk * a; if (WITHV) kpv[t] = k * (1.0f + (a - 1.0f) * kac);
        }
    }
    float gam = 1.f, pb[16];
#pragma unroll
    for (int t = 0; t < 16; ++t) {
        const float gp = gam; gam *= wv[t]; const float ig = __builtin_amdgcn_rcpf(gam);
        if (WITHY) pb[t] = rv[t] * kpv[t] * rk;
        bv[t] *= ig;
        *(LAS unsigned short*)(wl + WY_TA + t * 144 + lane * 2) = (unsigned short)f2bf(-gp * kkv[t]);
        *(LAS unsigned short*)(wl + WY_TB + t * 144 + lane * 2) = (unsigned short)f2bf(bv[t]);
        if (WITHV) { kpv[t] *= ig; *(LAS unsigned short*)(wl + WY_TK + t * 144 + lane * 2) = (unsigned short)f2bf(kpv[t]); }
        if (WITHY) *(LAS unsigned short*)(wl + WY_TR + t * 144 + lane * 2) = (unsigned short)f2bf(gam * rv[t]);
    }
    if (WITHY) {
        float q8[8], q4[4], q2[2], q1;
        { const bool hi = (lane & 32) != 0;
#pragma unroll
          for (int i = 0; i < 8; ++i) { const float keep = hi ? pb[i + 8] : pb[i], send = hi ? pb[i] : pb[i + 8]; q8[i] = keep + __shfl_xor(send, 32); } }
        { const bool hi = (lane & 16) != 0;
#pragma unroll
          for (int i = 0; i < 4; ++i) { const float keep = hi ? q8[i + 4] : q8[i], send = hi ? q8[i] : q8[i + 4]; q4[i] = keep + __shfl_xor(send, 16); } }
        { const bool hi = (lane & 8) != 0;
#pragma unroll
          for (int i = 0; i < 2; ++i) { const float keep = hi ? q4[i + 2] : q4[i], send = hi ? q4[i] : q4[i + 2]; q2[i] = keep + __shfl_xor(send, 8); } }
        { const bool hi = (lane & 4) != 0; const float keep = hi ? q2[1] : q2[0], send = hi ? q2[0] : q2[1]; q1 = keep + __shfl_xor(send, 4); }
        q1 += __shfl_xor(q1, 2); q1 += __shfl_xor(q1, 1);
        const int tk = ((lane >> 5) & 1) * 8 + ((lane >> 4) & 1) * 4 + ((lane >> 3) & 1) * 2 + ((lane >> 2) & 1);
        if ((lane & 3) == 0) *(LAS float*)(wl + WY_BON + tk * 4) = q1;
    }
    *(LAS float*)(wl + WY_GC + lane * 4) = gam;
    v4u o0, o1;
    o0.x = pk2(bv[0] * gam, bv[1] * gam); o0.y = pk2(bv[2] * gam, bv[3] * gam); o0.z = pk2(bv[4] * gam, bv[5] * gam); o0.w = pk2(bv[6] * gam, bv[7] * gam);
    o1.x = pk2(bv[8] * gam, bv[9] * gam); o1.y = pk2(bv[10] * gam, bv[11] * gam); o1.z = pk2(bv[12] * gam, bv[13] * gam); o1.w = pk2(bv[14] * gam, bv[15] * gam);
    *(LAS v4u*)(wl + WY_CB + lane * 32) = o0; *(LAS v4u*)(wl + WY_CB + lane * 32 + 16) = o1;
    if (WITHV) {
        o0.x = pk2(kpv[0] * gam, kpv[1] * gam); o0.y = pk2(kpv[2] * gam, kpv[3] * gam); o0.z = pk2(kpv[4] * gam, kpv[5] * gam); o0.w = pk2(kpv[6] * gam, kpv[7] * gam);
        o1.x = pk2(kpv[8] * gam, kpv[9] * gam); o1.y = pk2(kpv[10] * gam, kpv[11] * gam); o1.z = pk2(kpv[12] * gam, kpv[13] * gam); o1.w = pk2(kpv[14] * gam, kpv[15] * gam);
        *(LAS v4u*)(wl + WY_CK + lane * 32) = o0; *(LAS v4u*)(wl + WY_CK + lane * 32 + 16) = o1;
        o0.x = pk2(vt[0], vt[1]); o0.y = pk2(vt[2], vt[3]); o0.z = pk2(vt[4], vt[5]); o0.w = pk2(vt[6], vt[7]);
        o1.x = pk2(vt[8], vt[9]); o1.y = pk2(vt[10], vt[11]); o1.z = pk2(vt[12], vt[13]); o1.w = pk2(vt[14], vt[15]);
        *(LAS v4u*)(wl + WY_VT + lane * 32) = o0; *(LAS v4u*)(wl + WY_VT + lane * 32 + 16) = o1;
    }
    LDS_WAIT(); asm volatile("" ::: "memory");
}
__device__ __forceinline__ bf16x8 wy_nat(const LAS unsigned char* img, int ql, int g, int s) { return *(const LAS bf16x8*)(img + ql * 144 + 64 * s + 16 * g); }
__device__ __forceinline__ bf16x8 wy_perm(const LAS unsigned char* img, int ql, int g, int s) {
    return frag_2(*(const LAS v2u*)(img + ql * 144 + 64 * s + 8 * g), *(const LAS v2u*)(img + ql * 144 + 64 * s + 32 + 8 * g)); }
__device__ __forceinline__ bf16x8 wy_tok4(const LAS unsigned char* img, int row, int g) { return frag_lo(*(const LAS v2u*)(img + row * 32 + 8 * g)); }
template <int I> __device__ __forceinline__ void wy_solve(float (&z)[4][4], const float (&pab)[4], int ql) {
    if constexpr (I < 15) {
        float u[4];
#pragma unroll
        for (int ct = 0; ct < 4; ++ct) u[ct] = __shfl(z[ct][I & 3], ql + 16 * (I >> 2));
        asm volatile("s_nop 1");
#pragma unroll
        for (int ct = 0; ct < 4; ++ct) {
            fmac_bc<I>(z[ct][0], pab[0], u[ct]); fmac_bc<I>(z[ct][1], pab[1], u[ct]); fmac_bc<I>(z[ct][2], pab[2], u[ct]); fmac_bc<I>(z[ct][3], pab[3], u[ct]); }
        wy_solve<I + 1>(z, pab, ql);
    }
}
template <bool WITHV, bool WITHY>
__device__ __forceinline__ void wy_block(f32x4 (&acc)[4][4], f32x4 (&y)[4], LAS unsigned char* wl, int lane) {
    asm volatile("" : "+v"(lane));
    const int ql = lane & 15, g = lane >> 4;
    const f32x4 zero4 = {0.f, 0.f, 0.f, 0.f};
    f32x4 pab = zero4;
    {
        const bf16x8 a0 = wy_nat(wl + WY_TA, ql, g, 0), a1 = wy_nat(wl + WY_TA, ql, g, 1), b0 = wy_nat(wl + WY_TB, ql, g, 0), b1 = wy_nat(wl + WY_TB, ql, g, 1);
        pab = WY_MFMA(a0, b0, pab); pab = WY_MFMA(a1, b1, pab);
#pragma unroll
        for (int r = 0; r < 4; ++r) pab[r] = (4 * g + r > ql) ? pab[r] : 0.f;
        if (WITHV) {
            const bf16x8 k0 = wy_nat(wl + WY_TK, ql, g, 0), k1 = wy_nat(wl + WY_TK, ql, g, 1);
            f32x4 p = WY_MFMA(a0, k0, zero4); p = WY_MFMA(a1, k1, p);
#pragma unroll
            for (int r = 0; r < 4; ++r) *(LAS unsigned short*)(wl + WY_PK + (4 * g + r) * 32 + ql * 2) = (unsigned short)f2bf((4 * g + r > ql) ? p[r] : 0.f);
            if (WITHY) {
                const bf16x8 r0 = wy_nat(wl + WY_TR, ql, g, 0), r1 = wy_nat(wl + WY_TR, ql, g, 1);
                f32x4 q = WY_MFMA(r0, b0, zero4); q = WY_MFMA(r1, b1, q);
#pragma unroll
                for (int r = 0; r < 4; ++r) *(LAS unsigned short*)(wl + WY_PRB + (4 * g + r) * 32 + ql * 2) = (unsigned short)f2bf((4 * g + r >= ql) ? q[r] : 0.f);
                q = WY_MFMA(r0, k0, zero4); q = WY_MFMA(r1, k1, q);
#pragma unroll
                for (int r = 0; r < 4; ++r) *(LAS unsigned short*)(wl + WY_PRK + (4 * g + r) * 32 + ql * 2) = (unsigned short)f2bf((4 * g + r >= ql) ? q[r] : 0.f);
            }
        }
    }
    bf16x8 hf[2][4];
#pragma unroll
    for (int s = 0; s < 2; ++s)
#pragma unroll
        for (int ct = 0; ct < 4; ++ct) hf[s][ct] = frag_2(pack4(acc[2 * s][ct]), pack4(acc[2 * s + 1][ct]));
    LDS_WAIT(); asm volatile("" ::: "memory");
    f32x4 z[4];
    bf16x8 vf[4];
    {
        const bf16x8 a0 = wy_perm(wl + WY_TA, ql, g, 0), a1 = wy_perm(wl + WY_TA, ql, g, 1);
#pragma unroll
        for (int ct = 0; ct < 4; ++ct) { z[ct] = WY_MFMA(a0, hf[0][ct], zero4); z[ct] = WY_MFMA(a1, hf[1][ct], z[ct]); }
        if (WITHV) {
            const bf16x8 pk = wy_tok4(wl + WY_PK, ql, g);
#pragma unroll
            for (int ct = 0; ct < 4; ++ct) { vf[ct] = wy_tok4(wl + WY_VT, 16 * ct + ql, g); z[ct] = WY_MFMA(pk, vf[ct], z[ct]); }
        }
    }
    bf16x8 uf[4];
    {
        float zf[4][4], pf[4];
#pragma unroll
        for (int ct = 0; ct < 4; ++ct)
#pragma unroll
            for (int r = 0; r < 4; ++r) zf[ct][r] = z[ct][r];
#pragma unroll
        for (int r = 0; r < 4; ++r) pf[r] = pab[r];
        wy_solve<0>(zf, pf, ql);
#pragma unroll
        for (int ct = 0; ct < 4; ++ct) { v2u w; w.x = pg8::cvt_pk_bf16(zf[ct][0], zf[ct][1]); w.y = pg8::cvt_pk_bf16(zf[ct][2], zf[ct][3]); uf[ct] = frag_lo(w); }
    }
    if (WITHY) {
        const bf16x8 r0 = wy_perm(wl + WY_TR, ql, g, 0), r1 = wy_perm(wl + WY_TR, ql, g, 1), prb = wy_tok4(wl + WY_PRB, ql, g), prk = wy_tok4(wl + WY_PRK, ql, g);
#pragma unroll
        for (int ct = 0; ct < 4; ++ct) { y[ct] = WY_MFMA(r0, hf[0][ct], zero4); y[ct] = WY_MFMA(r1, hf[1][ct], y[ct]); y[ct] = WY_MFMA(prb, uf[ct], y[ct]); y[ct] = WY_MFMA(prk, vf[ct], y[ct]); }
    }
#pragma unroll
    for (int rt = 0; rt < 4; ++rt) {
        const f32x4 gc = *(const LAS f32x4*)(wl + WY_GC + (16 * rt + 4 * g) * 4);
        const bf16x8 bb = wy_tok4(wl + WY_CB, 16 * rt + ql, g);
        bf16x8 kb; if (WITHV) kb = wy_tok4(wl + WY_CK, 16 * rt + ql, g);
#pragma unroll
        for (int ct = 0; ct < 4; ++ct) { f32x4 a = acc[rt][ct] * gc; a = WY_MFMA(bb, uf[ct], a); if (WITHV) a = WY_MFMA(kb, vf[ct], a); acc[rt][ct] = a; }
    }
}

template <bool TYPE1>
__device__ __forceinline__ void wy_summary(unsigned char* ws, float* MN, const float* PREV, LAS unsigned char* wl, int bh, int ch, int lane, const float* k_k, const float* k_a) {
    const float* PRE = (const float*)(ws + WS_PRE);
    const float kkc = k_k[(bh & 7) * 64 + lane], kac = k_a[(bh & 7) * 64 + lane];
    const int ql = lane & 15, g = lane >> 4, b = bh >> 3, h = bh & 7, t0 = b * SEQ + ch * RCH;
    f32x4 acc[4][4], y[4];
#pragma unroll
    for (int rt = 0; rt < 4; ++rt)
#pragma unroll
        for (int ct = 0; ct < 4; ++ct)
#pragma unroll
            for (int r = 0; r < 4; ++r) acc[rt][ct][r] = (!TYPE1 && rt == ct && (4 * g + r == ql)) ? 1.f : 0.f;
    for (int blk = 0; blk < RCH / 16; ++blk) { wy_prep<TYPE1, false>(wl, PRE, PREV, t0 + 16 * blk, h, lane, 0.f, kkc, kac); wy_block<TYPE1, false>(acc, y, wl, lane); }
    float* dst = MN + ((size_t)(bh * NCH + ch) * 2 + (TYPE1 ? 1 : 0)) * 4096 + (TYPE1 ? (ql * 64 + 4 * g) : (4 * g * 64 + ql));
    asm volatile("" : "+v"(dst));
#pragma unroll
    for (int rt = 0; rt < 4; ++rt)
#pragma unroll
        for (int ct = 0; ct < 4; ++ct) {
            if (TYPE1) *(f32x4*)(dst + (16 * ct) * 64 + 16 * rt) = acc[rt][ct];
            else {
#pragma unroll
                for (int r = 0; r < 4; ++r) dst[(16 * rt + r) * 64 + 16 * ct] = acc[rt][ct][r];
            }
        }
}
__device__ __forceinline__ void phase_p3_wy(unsigned char* ws, float* MN, const float* PREV, const float* k_k, const float* k_a, LAS unsigned char* lds, int gw, int NGW, int wave, int lane) {
    LAS unsigned char* wl = lds + wave * WY_WRB;
    for (int it = gw; it < 16 * NCH * 2; it += NGW) {
        const int type = __builtin_amdgcn_readfirstlane(it & 1), ch = __builtin_amdgcn_readfirstlane((it >> 1) & (NCH - 1)), bh = __builtin_amdgcn_readfirstlane(it >> 8);
        if (type) wy_summary<true>(ws, MN, PREV, wl, bh, ch, lane, k_k, k_a); else wy_summary<false>(ws, MN, PREV, wl, bh, ch, lane, k_k, k_a);
    }
}
__device__ __forceinline__ void phase_p5_rwkv_wy(unsigned char* ws, const float* PREV, const float* G, const float* r_k, const float* lnx_g, const float* lnx_b, const float* k_k, const float* k_a, LAS unsigned char* lds, int gw, int NGW, int wave, int lane) {
    const float* PRE = (const float*)(ws + WS_PRE); const float* HC = (const float*)(ws + WS_HC); bf16* YB = (bf16*)(ws + WS_YB);
    LAS unsigned char* wl = lds + wave * WY_WRB;
    const int ql = lane & 15, g = lane >> 4;
    for (int it = gw; it < 16 * NCH; it += NGW) {
        const int ch = __builtin_amdgcn_readfirstlane(it & (NCH - 1)), bh = __builtin_amdgcn_readfirstlane(it >> 7), b = bh >> 3, h = bh & 7;
        const int t0 = b * SEQ + ch * RCH;
        f32x4 acc[4][4], y[4];
        const float* src = HC + (size_t)(bh * NCH + ch) * 4096 + ql * 64 + 4 * g;
        asm volatile("" : "+v"(src));
#pragma unroll
        for (int rt = 0; rt < 4; ++rt)
#pragma unroll
            for (int ct = 0; ct < 4; ++ct) acc[rt][ct] = *(const f32x4*)(src + (16 * ct) * 64 + 16 * rt);
        const float rk = r_k[h * 64 + lane], kkc = k_k[h * 64 + lane], kac = k_a[h * 64 + lane];
        float lg[4], lb[4];
#pragma unroll
        for (int ct = 0; ct < 4; ++ct) { lg[ct] = lnx_g[h * 64 + 16 * ct + ql]; lb[ct] = lnx_b[h * 64 + 16 * ct + ql]; }
        for (int blk = 0; blk < RCH / 16; ++blk) {
            const int tb = t0 + 16 * blk;
            wy_prep<true, true>(wl, PRE, PREV, tb, h, lane, rk, kkc, kac);
            float vv[4][4], gg[4][4];
            {
                const float* pvb = PREV + (size_t)tb * 512 + h * 64; const float* pgb = G + (size_t)tb * 512 + h * 64;
                const unsigned eo = (unsigned)(4 * g * 512 + ql);
#pragma unroll
                for (int r = 0; r < 4; ++r)
#pragma unroll
                    for (int ct = 0; ct < 4; ++ct) { vv[r][ct] = (pvb + (r * 512 + 16 * ct))[eo]; gg[r][ct] = (pgb + (r * 512 + 16 * ct))[eo]; }
            }
            wy_block<true, true>(acc, y, wl, lane);
#pragma unroll
            for (int r = 0; r < 4; ++r) {
                float s = (y[0][r] + y[1][r]) + (y[2][r] + y[3][r]);
                s += __shfl_xor(s, 1); s += __shfl_xor(s, 2); s += __shfl_xor(s, 4); s += __shfl_xor(s, 8);
                const float mean = s * (1.0f / 64.0f);
                float d[4], q = 0.f;
#pragma unroll
                for (int ct = 0; ct < 4; ++ct) { d[ct] = y[ct][r] - mean; q += d[ct] * d[ct]; }
                q += __shfl_xor(q, 1); q += __shfl_xor(q, 2); q += __shfl_xor(q, 4); q += __shfl_xor(q, 8);
                const float rstd = rsqrtf(q * (1.0f / 64.0f) + GN_EPS);
                const float bn = *(const LAS float*)(wl + WY_BON + (4 * g + r) * 4);
                bf16* yb = YB + (size_t)tb * 1024 + 512 + h * 64; const unsigned yo = (unsigned)((4 * g + r) * 1024 + ql);
#pragma unroll
                for (int ct = 0; ct < 4; ++ct) (yb + 16 * ct)[yo] = (bf16)f2bf((d[ct] * rstd * lg[ct] + lb[ct] + bn * vv[r][ct]) * gg[r][ct]);
            }
        }
    }
}

constexpr int WRS2 = 2064;
__device__ __forceinline__ void phase_p8(const float* PRE1, const float* ln_g, const float* ln_b, const float* w_router, const float* b_router,
                                         unsigned char* ws, LAS unsigned char* lds, LAS unsigned* hist, int blk, int G, int tid, int wave, int lane, bool count) {
    LAS unsigned char* whi = lds; LAS unsigned char* wlo = lds + 32 * WRS2;
    for (int i0 = 0; i0 < 64; i0 += 16) {
        float wv[16];
#pragma unroll
        for (int i = 0; i < 16; ++i) wv[i] = w_router[tid + NTHR * (i0 + i)];
#pragma unroll
        for (int i = 0; i < 16; ++i) { const int idx = tid + NTHR * (i0 + i); const float w = wv[i]; const unsigned h = f2bf(w); const unsigned l = f2bf(w - bf2f(h));
            const int e = idx & 31, k = idx >> 5; *(LAS unsigned short*)(whi + e * WRS2 + k * 2) = (unsigned short)h; *(LAS unsigned short*)(wlo + e * WRS2 + k * 2) = (unsigned short)l; }
    }
    if (tid < 32) hist[tid] = 0u;
    __syncthreads();
    bf16* HB = (bf16*)(ws + WS_HB); bf16* HBL = (bf16*)(ws + WS_XG); float* STATS = (float*)(ws + WS_STATS); int* TOPE = (int*)(ws + WS_TOPE); float* TOPG = (float*)(ws + WS_TOPG);
    const int ql = lane & 15, g = lane >> 4;
    f32x4 lg4[4], lb4[4];
#pragma unroll
    for (int j = 0; j < 4; ++j) { lg4[j] = *(const f32x4*)(ln_g + 256 * j + 4 * lane); lb4[j] = *(const f32x4*)(ln_b + 256 * j + 4 * lane); }
    for (int tb = (blk * NWAVES + wave) * 16; tb < T; tb += G * NWAVES * 16) {
        for (int q0 = 0; q0 < 16; q0 += 4) {
            f32x4 x[4][4];
#pragma unroll
            for (int q = 0; q < 4; ++q)
#pragma unroll
                for (int j = 0; j < 4; ++j) x[q][j] = __builtin_nontemporal_load((const f32x4*)(PRE1 + (size_t)(tb + q0 + q) * 1024 + 256 * j + 4 * lane));
#pragma unroll
            for (int q = 0; q < 4; ++q) {
                const int t = tb + q0 + q; float s = 0.f;
#pragma unroll
                for (int j = 0; j < 4; ++j) s += (x[q][j][0] + x[q][j][1]) + (x[q][j][2] + x[q][j][3]);
                const float mean = wave_sum(s) * (1.0f / 1024.0f); float s2 = 0.f;
#pragma unroll
                for (int j = 0; j < 4; ++j) { x[q][j] = x[q][j] - mean; s2 += (x[q][j][0] * x[q][j][0] + x[q][j][1] * x[q][j][1]) + (x[q][j][2] * x[q][j][2] + x[q][j][3] * x[q][j][3]); }
                const float rstd = rsqrtf(wave_sum(s2) * (1.0f / 1024.0f) + LN_EPS);
                if (lane == 0) { STATS[(size_t)t * 2] = mean; STATS[(size_t)t * 2 + 1] = rstd; }
#pragma unroll
                for (int j = 0; j < 4; ++j) { const f32x4 hh = x[q][j] * rstd * lg4[j] + lb4[j];
                    v2u hi; hi.x = pk2(hh[0], hh[1]); hi.y = pk2(hh[2], hh[3]);
                    v2u lo; lo.x = pk2(hh[0] - bflo(hi.x), hh[1] - bfhi(hi.x)); lo.y = pk2(hh[2] - bflo(hi.y), hh[3] - bfhi(hi.y));
                    *(v2u*)(HB + (size_t)t * 1024 + 256 * j + 4 * lane) = hi; *(v2u*)(HBL + (size_t)t * 1024 + 256 * j + 4 * lane) = lo; }
            }
        }
        VM_WAIT();
        f32x4 acc0 = {0.f, 0.f, 0.f, 0.f}, acc1 = acc0;
        const bf16* arow = HB + (size_t)(tb + ql) * 1024 + 8 * g; const bf16* lrow = HBL + (size_t)(tb + ql) * 1024 + 8 * g;
        const LAS unsigned char* b0p = whi + ql * WRS2 + 16 * g; const LAS unsigned char* b1p = whi + (16 + ql) * WRS2 + 16 * g;
#pragma unroll 1
        for (int s0 = 0; s0 < 32; s0 += 8) {
            bf16x8 ah[8], al[8];
#pragma unroll
            for (int i = 0; i < 8; ++i) { ah[i] = *(const bf16x8*)(arow + 32 * (s0 + i)); al[i] = *(const bf16x8*)(lrow + 32 * (s0 + i)); }
#pragma unroll
            for (int i = 0; i < 8; ++i) {
                const int so = 64 * (s0 + i);
                const bf16x8 bh0 = *(const LAS bf16x8*)(b0p + so), bl0 = *(const LAS bf16x8*)(b0p + 32 * WRS2 + so), bh1 = *(const LAS bf16x8*)(b1p + so), bl1 = *(const LAS bf16x8*)(b1p + 32 * WRS2 + so);
                acc0 = __builtin_amdgcn_mfma_f32_16x16x32_bf16(ah[i], bh0, acc0, 0, 0, 0); acc0 = __builtin_amdgcn_mfma_f32_16x16x32_bf16(al[i], bh0, acc0, 0, 0, 0); acc0 = __builtin_amdgcn_mfma_f32_16x16x32_bf16(ah[i], bl0, acc0, 0, 0, 0);
                acc1 = __builtin_amdgcn_mfma_f32_16x16x32_bf16(ah[i], bh1, acc1, 0, 0, 0); acc1 = __builtin_amdgcn_mfma_f32_16x16x32_bf16(al[i], bh1, acc1, 0, 0, 0); acc1 = __builtin_amdgcn_mfma_f32_16x16x32_bf16(ah[i], bl1, acc1, 0, 0, 0);
            }
        }
        const float br0 = b_router[ql], br1 = b_router[16 + ql];
#pragma unroll
        for (int r = 0; r < 4; ++r) {
            float v0 = acc0[r] + br0, v1 = acc1[r] + br1; float tv[4]; int te[4];
#pragma unroll
            for (int rd = 0; rd < 4; ++rd) {
                float bv = (v0 >= v1) ? v0 : v1; int bi = (v0 >= v1) ? ql : 16 + ql;
#pragma unroll
                for (int off = 1; off < 16; off <<= 1) { const float ov = __shfl_xor(bv, off); const int oi = __shfl_xor(bi, off); const bool take = (ov > bv) || (ov == bv && oi < bi); bv = take ? ov : bv; bi = take ? oi : bi; }
                tv[rd] = bv; te[rd] = bi; if (bi == ql) v0 = -__builtin_inff(); if (bi == 16 + ql) v1 = -__builtin_inff();
            }
            const float e1 = __expf(tv[1] - tv[0]), e2 = __expf(tv[2] - tv[0]), e3 = __expf(tv[3] - tv[0]); const float inv = 1.0f / (((1.0f + e1) + e2) + e3);
            const float gsel = ql == 0 ? inv : ql == 1 ? e1 * inv : ql == 2 ? e2 * inv : e3 * inv;
            const int esel = ql == 0 ? te[0] : ql == 1 ? te[1] : ql == 2 ? te[2] : te[3];
            const int t = tb + 4 * g + r;
            if (ql < 4) { TOPE[(size_t)t * 4 + ql] = esel; TOPG[(size_t)t * 4 + ql] = gsel; lds_add(&hist[esel], 1u); }
        }
    }
    __syncthreads();
    if (count && tid < 32 && hist[tid]) atomicAdd((unsigned*)(ws + WS_CTL) + CW_ECNT + tid, hist[tid]);
}

__device__ __forceinline__ void phase_p9(const float* w1, const float* w2, unsigned char* ws, LAS unsigned char* lds, LAS unsigned* sm  , int blk, int G, int gw, int NGW, int tid, int wave, int lane) {
    unsigned* CTL = (unsigned*)(ws + WS_CTL);
    LAS unsigned* pstart = sm; LAS unsigned* lhist = sm + 32; LAS unsigned* lbase = sm + 64; LAS unsigned* slotOf = sm + 96;
    const int* TOPE = (const int*)(ws + WS_TOPE); const float* TOPG = (const float*)(ws + WS_TOPG); int* TOKSLOT = (int*)(ws + WS_TOKSLOT); float* SLOTG = (float*)(ws + WS_SLOTG);
    int* ROWIDX = (int*)(ws + WS_ROWIDX); int* TILEE = (int*)(ws + WS_TILEE);
    if (tid == 0) { unsigned acc = 0u; for (int e = 0; e < 32; ++e) { pstart[e] = acc; acc += ((CTL[CW_ECNT + e] + 255u) >> 8) << 8; }
        if (blk == 0) CTL[CW_NTILES] = acc >> 8; }
    __syncthreads();
    if (blk == 0) {
        for (int pm = tid; pm < NTILE_MAX; pm += NTHR) { const unsigned row = (unsigned)pm * 256u; int e = 0;
#pragma unroll 4
            for (int q = 1; q < 32; ++q) if (row >= pstart[q]) e = q;
            TILEE[pm] = e; }
    }
    for (int chunk = blk; chunk < T / 128; chunk += G) {
        if (tid < 32) lhist[tid] = 0u;
        __syncthreads();
        const int t = chunk * 128 + (tid >> 2), k = tid & 3; const int e = TOPE[(size_t)t * 4 + k];
        const unsigned rank = lds_add(&lhist[e], 1u);
        __syncthreads();
        if (tid < 32) lbase[tid] = lhist[tid] ? atomicAdd(&CTL[CW_ECUR + tid], lhist[tid]) : 0u;
        __syncthreads();
        const unsigned slot = pstart[e] + lbase[e] + rank;
        TOKSLOT[(size_t)t * 4 + k] = (int)slot; SLOTG[slot] = TOPG[(size_t)t * 4 + k]; ROWIDX[slot] = t;
        __syncthreads();
    }
    LAS float* scr = (LAS float*)(lds + wave * 16384);
    bf16* W1T = (bf16*)(ws + WS_W1T); bf16* W2T = (bf16*)(ws + WS_W2T);
    constexpr int I1 = 16 * 64, I2 = 16 * 32;
    REPS(10) for (int it = gw; it < NEXP * (I1 + I2); it += NGW) {
        if (it < NEXP * I1) { const int e = it / I1, r = it % I1; transpose_item<false>(w1 + (size_t)e * 1024 * 2048, 2048, W1T + (size_t)e * 2048 * 1024, 1024, 64 * (r / 64), 32 * (r % 64), 0, scr, lane); }
        else { const int r0 = it - NEXP * I1, e = r0 / I2, r = r0 % I2; transpose_item<false>(w2 + (size_t)e * 1024 * 1024, 1024, W2T + (size_t)e * 1024 * 1024, 1024, 64 * (r / 32), 32 * (r % 32), 0, scr, lane); }
    }
}

__device__ __forceinline__ void phase_final(float* OUT  , float* OUTW, const float* ln1_g, const float* ln1_b, const float* ln2_g, const float* ln2_b, unsigned char* ws, int gw, int NGW, int lane) {
    const float* STATS = (const float*)(ws + WS_STATS); const int* TOKSLOT = (const int*)(ws + WS_TOKSLOT); const bf16* YS = (const bf16*)(ws + WS_YS);
    f32x4 g1[4], b1[4], g2[4], b2[4];
#pragma unroll
    for (int j = 0; j < 4; ++j) { const int col = 256 * j + 4 * lane; g1[j] = *(const f32x4*)(ln1_g + col) * ALPHA; b1[j] = *(const f32x4*)(ln1_b + col) * ALPHA; g2[j] = *(const f32x4*)(ln2_g + col); b2[j] = *(const f32x4*)(ln2_b + col); }
    for (int t0 = gw * 2; t0 < T; t0 += NGW * 2) {
        float mean[2], rstd[2]; int sl[2][4]; f32x4 x[2][4]; v2u ys[2][4][4];
#pragma unroll
        for (int q = 0; q < 2; ++q) { const int t = t0 + q; mean[q] = STATS[(size_t)t * 2]; rstd[q] = STATS[(size_t)t * 2 + 1];
#pragma unroll
            for (int k = 0; k < 4; ++k) sl[q][k] = TOKSLOT[(size_t)t * 4 + k];
#pragma unroll
            for (int j = 0; j < 4; ++j) x[q][j] = __builtin_nontemporal_load((const f32x4*)(OUT + (size_t)t * 1024 + 256 * j + 4 * lane)); }
#pragma unroll
        for (int q = 0; q < 2; ++q)
#pragma unroll
            for (int k = 0; k < 4; ++k)
#pragma unroll
                for (int j = 0; j < 4; ++j) ys[q][k][j] = __builtin_nontemporal_load((const v2u*)(YS + (size_t)sl[q][k] * 1024 + 256 * j + 4 * lane));
#pragma unroll
        for (int q = 0; q < 2; ++q) {
            const int t = t0 + q; f32x4 z[4]; float s = 0.f;
#pragma unroll
            for (int j = 0; j < 4; ++j) {
                f32x4 h = (x[q][j] - mean[q]) * rstd[q] * g1[j] + b1[j];
                const v2u y0 = ys[q][0][j], y1 = ys[q][1][j], y2 = ys[q][2][j], y3 = ys[q][3][j];
                h[0] += (bflo(y0.x) + bflo(y1.x)) + (bflo(y2.x) + bflo(y3.x)); h[1] += (bfhi(y0.x) + bfhi(y1.x)) + (bfhi(y2.x) + bfhi(y3.x));
                h[2] += (bflo(y0.y) + bflo(y1.y)) + (bflo(y2.y) + bflo(y3.y)); h[3] += (bfhi(y0.y) + bfhi(y1.y)) + (bfhi(y2.y) + bfhi(y3.y));
                z[j] = h; s += (h[0] + h[1]) + (h[2] + h[3]); }
            const float m2 = wave_sum(s) * (1.0f / 1024.0f); float qq = 0.f;
#pragma unroll
            for (int j = 0; j < 4; ++j) { z[j] = z[j] - m2; qq += (z[j][0] * z[j][0] + z[j][1] * z[j][1]) + (z[j][2] * z[j][2] + z[j][3] * z[j][3]); }
            const float r2 = rsqrtf(wave_sum(qq) * (1.0f / 1024.0f) + LN_EPS);
#pragma unroll
            for (int j = 0; j < 4; ++j) __builtin_nontemporal_store(z[j] * r2 * g2[j] + b2[j], (f32x4*)(OUTW + (size_t)t * 1024 + 256 * j + 4 * lane));
        }
    }
}

#ifndef MK_PER_PHASE
#define MK_PER_PHASE 0
#endif
constexpr int NPHASE = 14;
struct Args { const float* in[26]; float* out; unsigned char* ws; int ph_lo, ph_hi; };

__global__ void __launch_bounds__(NTHR, 2) hybrid_fwd(Args args) {
    extern __shared__ __attribute__((aligned(16))) unsigned char lds_raw[];
    LAS unsigned char* lds = (LAS unsigned char*)lds_raw;
    volatile LAS unsigned* MISC = (volatile LAS unsigned*)(lds + MISC_OFF);
    const int tid = threadIdx.x, lane = tid & 63, wave = __builtin_amdgcn_readfirstlane(tid >> 6);
    const int G = gridDim.x, bx = blockIdx.x;
    const int vcu = (G % 8 == 0) ? (bx % 8) * (G / 8) + bx / 8 : bx;
    const int gw = vcu * NWAVES + wave, NGW = G * NWAVES;
    unsigned char* ws = args.ws;
    unsigned* CTL = (unsigned*)(ws + WS_CTL);
    for (int u = tid; u < (LDS_BYTES - MISC_OFF) / 4; u += NTHR) MISC[u] = 0u;
    __syncthreads();
    XcdBarrier bar; bar.bar = CTL + CW_BAR; bar.x = 0; bar.st = nullptr;
    if (!MK_PER_PHASE) bar = xcd_barrier_post(CTL + CW_BAR, MISC);
    const int lo = args.ph_lo, hi = args.ph_hi;
#ifndef PH_MASK
#define PH_MASK 0x3fff
#endif
#define IN(k) ((((PH_MASK) >> (k)) & 1) && lo <= (k) && (k) < hi)
#define SEAM(k) do { if (IN(k) && IN((k) + 1)) xcd_barrier(bar); } while (0)
#define RSH(k) (((REPEAT_MASK) >> (k)) & 1)
    const float* x = args.in[0];
    float* OUT = args.out;
    float* PREV = OUT;
    float* GG = OUT + (size_t)T * 512;

    if (IN(0)) REPS(0) { phase_p0(x, args.in[1], args.in[13], args.in[14], args.in[15], args.in[4], args.in[6], args.in[7], ws, lds, gw, NGW, wave, lane); }
    SEAM(0);
    if (IN(1)) {
        pg8::Gemm g{(const bf16*)(ws + WS_XB), (const bf16*)(ws + WS_WIN), 1024, 1024, 1024};
        GridOrder S; S.init(T / 256, NPROJ / 256, G, bx, 0u, RSH(1));
        EpiProj E{(bf16*)(ws + WS_QR), (bf16*)(ws + WS_KR), (bf16*)(ws + WS_VR), (bf16*)(ws + WS_SGA), (bf16*)(ws + WS_SGR), (float*)(ws + WS_KMEAN), (const float*)(ws + WS_ROPE),
                  (float*)(ws + WS_PRE), PREV, (float*)(ws + WS_RW), (float*)(ws + WS_RW) + (size_t)(T / 64) * 2048, (bf16*)(ws + WS_APR), args.in[2]};
        pg8::gemm_phase<EpiProj, GridOrder>(lds, g, S, E);
    }
    SEAM(1);
    if (IN(2)) { REPS(2) phase_p2_fix(args.in[2], ws, PREV, gw, NGW, lane); REPS(16) phase_p2_gate(ws, lds, gw, NGW, wave, lane); }
    SEAM(2);
    if (IN(3)) {
        pg8::Gemm g{(const bf16*)(ws + WS_APR), (const bf16*)(ws + WS_WLORA), 256, 512, 256};
        GridOrder S; S.init(T / 256, 6, G, bx, 128u, 0);
        EpiLora E{(float*)(ws + WS_PRE), GG, args.in[3], args.in[5]};
        pg8::gemm_phase<EpiLora, GridOrder>(lds, g, S, E);
    }
    SEAM(3);
    if (IN(4)) REPS(4) { phase_p3_wy(ws, (float*)(ws + WS_MN), PREV, args.in[8], args.in[9], lds, gw, NGW, wave, lane); }
    SEAM(4);
    if (IN(5)) {
        if (bx < 16) REPS(14) phase_p4_chain(ws, lds, bx, wave, lane);
        LAS unsigned* uq = (LAS unsigned*)(lds + 65536 + 32768 + 64);
        REPS(15) {
            unsigned nxt = 0u;
            if (tid == 0) nxt = atomicAdd(CTL + CW_ATTQ + rep, 1u);
            for (;;) {
                __syncthreads();
                if (tid == 0) *uq = nxt;
                __syncthreads();
                const int un = (int)*uq;
                if (un >= 1008 + 1024) break;
                if (tid == 0) nxt = atomicAdd(CTL + CW_ATTQ + rep, 1u);
                if (un < 1008) attn_unit(ws, lds, un & 15, un >> 4, false, tid, wave, lane);
                else attn_unit(ws, lds, (un - 1008) & 15, (un - 1008) >> 4, true, tid, wave, lane);
            }
        }
    }
    SEAM(5);
    if (IN(6)) REPS(6) { phase_p5_merge(ws, gw, NGW, lane);
        phase_p5_rwkv_wy(ws, PREV, GG, args.in[10], args.in[11], args.in[12], args.in[8], args.in[9], lds, gw, NGW, wave, lane); }
    SEAM(6);
    if (IN(7)) {
        pg8::Gemm g{(const bf16*)(ws + WS_YB), (const bf16*)(ws + WS_WBR), 512, 1024, 1024};
        MixOrder S{G, bx, RSH(7)};
        EpiMix E{(bf16*)(ws + WS_MIXED), (const bf16*)(ws + WS_SGA), (const bf16*)(ws + WS_SGR)};
        pg8::gemm_phase<EpiMix, MixOrder>(lds, g, S, E);
    }
    SEAM(7);
    if (IN(8)) {
        pg8::Gemm g{(const bf16*)(ws + WS_MIXED), (const bf16*)(ws + WS_WOUT), 1024, 1024, 1024};
        GridOrder S; S.init(T / 256, 4, G, bx, 0u, RSH(8));
        EpiOut E{OUT, x};
        pg8::gemm_phase<EpiOut, GridOrder>(lds, g, S, E);
    }
    SEAM(8);
    if (IN(9)) REPS(9) { __syncthreads(); phase_p8(OUT, args.in[16], args.in[17], args.in[18], args.in[19], ws, lds, (LAS unsigned*)(lds + MISC_OFF + 256), bx, G, tid, wave, lane, rep == 0); }
    SEAM(9);
    if (IN(10)) { phase_p9(args.in[20], args.in[22], ws, lds, (LAS unsigned*)(lds + MISC_OFF + 512), bx, G, gw, NGW, tid, wave, lane); }
    SEAM(10);
    if (IN(11)) {
        pg8::Gemm g{(const bf16*)(ws + WS_HB), (const bf16*)(ws + WS_W1T), 1024, 1024, 1024, (const int*)(ws + WS_ROWIDX)};
        MoeOrder S{G, bx, 8, (int)__builtin_nontemporal_load(CTL + CW_NTILES), (const int*)(ws + WS_TILEE), 2048u * 1024u * 2u, RSH(11)};
        EpiW1 E{(bf16*)(ws + WS_ACT), args.in[21]};
        pg8::gemm_phase<EpiW1, MoeOrder, true>(lds, g, S, E);
    }
    SEAM(11);
    if (IN(12)) {
        pg8::Gemm g{(const bf16*)(ws + WS_ACT), (const bf16*)(ws + WS_W2T), 1024, 1024, 1024};
        MoeOrder S{G, bx, 4, (int)__builtin_nontemporal_load(CTL + CW_NTILES), (const int*)(ws + WS_TILEE), 1024u * 1024u * 2u, RSH(12)};
        EpiW2 E{(bf16*)(ws + WS_YS), args.in[23], (const float*)(ws + WS_SLOTG)};
        pg8::gemm_phase<EpiW2, MoeOrder>(lds, g, S, E);
    }
    SEAM(12);
    if (IN(13)) REPS(13) { phase_final(OUT, (rep == RSH(13)) ? OUT : (float*)(ws + WS_PRE), args.in[16], args.in[17], args.in[24], args.in[25], ws, gw, NGW, lane); }
#undef IN
#undef SEAM
}

extern "C" void kernel_launch(void* const* d_in, const int* in_sizes, int n_in, void* d_out, int out_size, void* d_ws, size_t ws_size, hipStream_t stream) {
    static int grid = 0;
    if (grid == 0) {
        if (n_in != 26 || out_size != T * D || ws_size < WS_END) { fprintf(stderr, "kernel_launch: unexpected shapes (n_in %d, out %d, ws %zu < %zu)\n", n_in, out_size, ws_size, (size_t)WS_END); grid = -1; return; }
        int dev = 0, cus = 0, per_cu = 0;
        if (hipGetDevice(&dev) != hipSuccess || hipDeviceGetAttribute(&cus, hipDeviceAttributeMultiprocessorCount, dev) != hipSuccess) { grid = -1; return; }
        if (hipFuncSetAttribute((const void*)hybrid_fwd, hipFuncAttributeMaxDynamicSharedMemorySize, LDS_BYTES) != hipSuccess) { fprintf(stderr, "kernel_launch: hipFuncSetAttribute failed\n"); grid = -1; return; }
        if (hipOccupancyMaxActiveBlocksPerMultiprocessor(&per_cu, (const void*)hybrid_fwd, NTHR, LDS_BYTES) != hipSuccess || per_cu < 1) { fprintf(stderr, "kernel_launch: occupancy query says %d blocks/CU\n", per_cu); }
        (void)hipGetLastError();
        grid = cus;
    }
    if (grid < 0) return;
    if (hipMemsetAsync((char*)d_ws + WS_CTL, 0, ZERO_BYTES, stream) != hipSuccess) { fprintf(stderr, "kernel_launch: memset failed\n"); return; }
    Args a{};
    for (int i = 0; i < 26; ++i) a.in[i] = (const float*)d_in[i];
    a.out = (float*)d_out; a.ws = (unsigned char*)d_ws;
#if MK_PER_PHASE
    for (int p = 0; p < NPHASE; ++p) { a.ph_lo = p; a.ph_hi = p + 1; hipLaunchKernelGGL(hybrid_fwd, dim3(grid), dim3(NTHR), LDS_BYTES, stream, a); }
#else
    a.ph_lo = 0; a.ph_hi = NPHASE;
    hipLaunchKernelGGL(hybrid_fwd, dim3(grid), dim3(NTHR), LDS_BYTES, stream, a);
#endif
    const hipError_t le = hipPeekAtLastError();
    if (le != hipSuccess) fprintf(stderr, "kernel_launch: launch failed: %s\n", hipGetErrorName(le));
}
```
